# Optimizing an MI355X kernel written in HIP

```python
import jax, jax.numpy as jnp
from jax import lax
import numpy as np

D_MODEL = 1024
BATCH = 8
SEQ = 2048
DEPTH = 2

N_SB_HEADS = 8
SB_HEAD_DIM = 64
SB_WIDTH = N_SB_HEADS * SB_HEAD_DIM
Q_BLOCK = 128
POOL_WINDOWS = (2, 4, 8, 16)
POOL_GROUPS = len(POOL_WINDOWS)
POOL_GROUP_DIM = 128
POOL_WIDTH = POOL_GROUPS * POOL_GROUP_DIM
CONV_WIDTH = 512
CONV_TAPS = 31
SG_GROUPS = 4
SG_GROUP_DIM = 128
SG_WIDTH = SG_GROUPS * SG_GROUP_DIM
SG_CHUNK = 128
EVEN_IN = 3 * SB_WIDTH + POOL_WIDTH
ODD_IN = 2 * CONV_WIDTH + 2 * SG_WIDTH
MIX_WIDTH = 1024
D_FF = -(-(8 * D_MODEL) // (3 * 256)) * 256
PLE_DIM = 256
N_EVEN = (DEPTH + 1) // 2
N_ODD = DEPTH // 2
ALPHA = (2 * DEPTH) ** 0.25
BETA_INIT = (8 * DEPTH) ** -0.25
LN_EPS = 1e-5

kernel_name = "hybrid_stickbreak_pool_conformer_gmlp"


def layer_norm(x, g, b):
    xf = x.astype(jnp.float32)
    mu = jnp.mean(xf, axis=-1, keepdims=True)
    var = jnp.mean(jnp.square(xf - mu), axis=-1, keepdims=True)
    y = (xf - mu) * lax.rsqrt(var + LN_EPS)
    return (y * g.astype(jnp.float32) + b.astype(jnp.float32)).astype(x.dtype)


def stick_breaking_attention(q, k, v):
    S = q.shape[1]
    scale = SB_HEAD_DIM ** -0.5
    outs = []
    for i in range(S // Q_BLOCK):
        q0, q1 = i * Q_BLOCK, (i + 1) * Q_BLOCK
        qb = q[:, q0:q1]
        kb = k[:, :q1]
        vb = v[:, :q1]
        z = jnp.einsum('bqhd,bkhd->bhqk', qb, kb).astype(jnp.float32) * scale
        t_idx = q0 + jnp.arange(Q_BLOCK)[:, None]
        s_idx = jnp.arange(q1)[None, :]
        mask = s_idx < t_idx
        log_keep = jnp.where(mask, jax.nn.log_sigmoid(-z), 0.0)
        between = lax.cumsum(log_keep, axis=3, reverse=True) - log_keep
        w = jnp.where(mask, jnp.exp(jax.nn.log_sigmoid(z) + between), 0.0)
        outs.append(jnp.einsum('bhqk,bkhd->bqhd', w.astype(vb.dtype), vb))
    return jnp.concatenate(outs, axis=1)


def causal_window_mean(u, w):
    B, S, C = u.shape
    c = jnp.cumsum(u.astype(jnp.float32), axis=1)
    c_pad = jnp.concatenate([jnp.zeros((B, 1, C), jnp.float32), c], axis=1)
    hi = c_pad[:, 1:]
    lo = jnp.pad(c_pad[:, :S + 1 - w], ((0, 0), (w - 1, 0), (0, 0)))
    count = jnp.minimum(jnp.arange(1, S + 1), w).astype(jnp.float32)[None, :, None]
    return ((hi - lo) / count).astype(u.dtype)


def multiscale_pool(u, pool_w, pool_scale):
    B, S, _ = u.shape
    ug = u.reshape(B, S, POOL_GROUPS, POOL_GROUP_DIM)
    pooled = jnp.stack([causal_window_mean(ug[:, :, g], w) - ug[:, :, g]
                        for g, w in enumerate(POOL_WINDOWS)], axis=2)
    mixed = jnp.einsum('bsgc,gcd->bsgd', pooled, pool_w)
    return mixed.reshape(B, S, POOL_WIDTH) * pool_scale


def even_mixer(x, w_in, w_out, pool_w, pool_scale):
    B, S, _ = x.shape
    h = x @ w_in
    q = h[..., :SB_WIDTH].reshape(B, S, N_SB_HEADS, SB_HEAD_DIM)
    k = h[..., SB_WIDTH:2 * SB_WIDTH].reshape(B, S, N_SB_HEADS, SB_HEAD_DIM)
    v = h[..., 2 * SB_WIDTH:3 * SB_WIDTH].reshape(B, S, N_SB_HEADS, SB_HEAD_DIM)
    u = h[..., 3 * SB_WIDTH:]
    a = stick_breaking_attention(q, k, v).reshape(B, S, SB_WIDTH)
    b = multiscale_pool(u, pool_w, pool_scale)
    return jnp.concatenate([a, b], axis=-1) @ w_out


def conformer_conv(a, g, dw, ln_g, ln_b):
    h = a * jax.nn.sigmoid(g)
    h = lax.conv_general_dilated(h, dw[:, None, :], window_strides=(1,),
                                 padding=[(CONV_TAPS - 1, 0)],
                                 dimension_numbers=('NWC', 'WIO', 'NWC'),
                                 feature_group_count=CONV_WIDTH)
    return jax.nn.silu(layer_norm(h, ln_g, ln_b))


def chunked_spatial_gating(zc, ln_g, ln_b, sg_w, sg_b):
    B, S, _ = zc.shape
    z = jax.nn.gelu(zc)
    u, v = z[..., :SG_WIDTH], z[..., SG_WIDTH:]
    v = layer_norm(v, ln_g, ln_b)
    vc = v.reshape(B, S // SG_CHUNK, SG_CHUNK, SG_GROUPS, SG_GROUP_DIM)
    mask = jnp.tril(jnp.ones((SG_CHUNK, SG_CHUNK), sg_w.dtype))
    sv = jnp.einsum('gts,bcsgd->bctgd', sg_w * mask[None], vc)
    sv = sv + sg_b.T[None, None, :, :, None]
    return u * sv.reshape(B, S, SG_WIDTH)


def odd_mixer(x, w_in, w_out, conv_dw, conv_ln_g, conv_ln_b, sg_ln_g, sg_ln_b, sg_w, sg_b):
    h = x @ w_in
    a = h[..., :CONV_WIDTH]
    g = h[..., CONV_WIDTH:2 * CONV_WIDTH]
    zc = h[..., 2 * CONV_WIDTH:]
    c_out = conformer_conv(a, g, conv_dw, conv_ln_g, conv_ln_b)
    d_out = chunked_spatial_gating(zc, sg_ln_g, sg_ln_b, sg_w, sg_b)
    return jnp.concatenate([c_out, d_out], axis=-1) @ w_out


def swiglu(x, w_gate, w_up, w_down):
    return (jax.nn.silu(x @ w_gate) * (x @ w_up)) @ w_down


def setup_inputs(seed: int = 0) -> dict:
    key = jax.random.key(seed)
    ks = iter(jax.random.split(key, 40))
    nrm = lambda shape, s: jax.random.normal(next(ks), shape, jnp.float32) * s
    d = D_MODEL
    return {
        "x": nrm((BATCH, SEQ, d), 1.0),
        "p": nrm((DEPTH, BATCH, SEQ, PLE_DIM), 1.0),
        "even_w_in": nrm((N_EVEN, d, EVEN_IN), d ** -0.5),
        "even_w_out": nrm((N_EVEN, MIX_WIDTH, d), MIX_WIDTH ** -0.5 * BETA_INIT),
        "pool_w": nrm((N_EVEN, POOL_GROUPS, POOL_GROUP_DIM, POOL_GROUP_DIM), POOL_GROUP_DIM ** -0.5),
        "pool_scale": 1.0 + nrm((N_EVEN, POOL_WIDTH), 0.02),
        "odd_w_in": nrm((N_ODD, d, ODD_IN), d ** -0.5),
        "odd_w_out": nrm((N_ODD, MIX_WIDTH, d), MIX_WIDTH ** -0.5 * BETA_INIT),
        "conv_dw": nrm((N_ODD, CONV_TAPS, CONV_WIDTH), CONV_TAPS ** -0.5),
        "conv_ln_g": 1.0 + nrm((N_ODD, CONV_WIDTH), 0.02),
        "conv_ln_b": nrm((N_ODD, CONV_WIDTH), 0.02),
        "sg_ln_g": 1.0 + nrm((N_ODD, SG_WIDTH), 0.02),
        "sg_ln_b": nrm((N_ODD, SG_WIDTH), 0.02),
        "sg_w": nrm((N_ODD, SG_GROUPS, SG_CHUNK, SG_CHUNK), SG_CHUNK ** -0.5),
        "sg_b": 1.0 + nrm((N_ODD, SG_GROUPS, SG_CHUNK), 0.1),
        "ln_mix_g": 1.0 + nrm((DEPTH, d), 0.02),
        "ln_mix_b": nrm((DEPTH, d), 0.02),
        "ffn_w_gate": nrm((DEPTH, d, D_FF), d ** -0.5),
        "ffn_w_up": nrm((DEPTH, d, D_FF), d ** -0.5),
        "ffn_w_down": nrm((DEPTH, D_FF, d), D_FF ** -0.5 * BETA_INIT),
        "ln_ffn_g": 1.0 + nrm((DEPTH, d), 0.02),
        "ln_ffn_b": nrm((DEPTH, d), 0.02),
        "ple_w_proj": nrm((DEPTH, PLE_DIM, d), PLE_DIM ** -0.5),
        "ple_w_gate": nrm((DEPTH, d, d), d ** -0.5),
        "ple_b_gate": nrm((DEPTH, d), 0.02),
    }


def reference(x, p, even_w_in, even_w_out, pool_w, pool_scale,
              odd_w_in, odd_w_out, conv_dw, conv_ln_g, conv_ln_b,
              sg_ln_g, sg_ln_b, sg_w, sg_b,
              ln_mix_g, ln_mix_b, ffn_w_gate, ffn_w_up, ffn_w_down,
              ln_ffn_g, ln_ffn_b, ple_w_proj, ple_w_gate, ple_b_gate):
    for i in range(DEPTH):
        j = i // 2
        if i % 2 == 0:
            mix = even_mixer(x, even_w_in[j], even_w_out[j], pool_w[j], pool_scale[j])
        else:
            mix = odd_mixer(x, odd_w_in[j], odd_w_out[j], conv_dw[j], conv_ln_g[j], conv_ln_b[j],
                            sg_ln_g[j], sg_ln_b[j], sg_w[j], sg_b[j])
        x = layer_norm(ALPHA * x + mix, ln_mix_g[i], ln_mix_b[i])
        x = layer_norm(ALPHA * x + swiglu(x, ffn_w_gate[i], ffn_w_up[i], ffn_w_down[i]),
                       ln_ffn_g[i], ln_ffn_b[i])
        gate = jax.nn.sigmoid(x @ ple_w_gate[i] + ple_b_gate[i])
        x = x + gate * (p[i] @ ple_w_proj[i])
    return x
```

```cpp
#include <hip/hip_runtime.h>
#include <hip/hip_cooperative_groups.h>
#include <cstdio>
#include <cstdint>
namespace cg = cooperative_groups;
namespace pg8 {
#define PG8_LAS __attribute__((address_space(3)))
typedef unsigned short bf16_t;
typedef short bf16x8 __attribute__((ext_vector_type(8)));
typedef float f32x4 __attribute__((ext_vector_type(4)));
typedef unsigned u32x4 __attribute__((ext_vector_type(4)));
constexpr int BM = 256, BK = 64, HALF = 128, HTB = HALF * BK * 2  , STAGE_BYTES = 8 * HTB, NXCD = 8, WGM = 8;

__host__ __device__ __forceinline__ int lds_byte(int r, int c) { const int st = (r >> 4) * 2 + (c >> 5), rr = r & 15, cc = c & 31, ob = rr * 64 + cc * 2; return st * 1024 + (ob ^ (((ob >> 9) & 1) << 5)); }
__host__ __device__ __forceinline__ void stage_rc(int b, int& R, int& C) { const int st = b / 1024, sb = b % 1024, swz = sb ^ (((sb >> 9) & 1) << 5); R = (st >> 1) * 16 + swz / 64; C = (st & 1) * 32 + (swz % 64) / 2; }
__host__ __device__ __forceinline__ int perm32(int rho) { const int n = rho >> 4, i = rho & 15; return 8 * (i >> 2) + 4 * n + (i & 3); }

struct Unit { int pm, pn; };
struct Gemm { const bf16_t* A; const bf16_t* Bt; int M, N, K; };

struct StaticOrder {
    int nM, nN, nwg, G, c;
    __host__ __device__ void init(int M, int N, int G_, int c_) { nM = M / BM; nN = N / BM; nwg = nM * nN; G = G_; c = c_; }
    __host__ __device__ bool next(int i, Unit& u) const {
        const long L = (long)i * G + c; if (L >= nwg) return false;
        int wgid = (int)L; { const int q = nwg / NXCD, r = nwg % NXCD, xcd = wgid % NXCD, off = wgid / NXCD; wgid = (xcd < r ? xcd * (q + 1) : r * (q + 1) + (xcd - r) * q) + off; }
        const int nig = WGM * nN, gid = wgid / nig, fm = gid * WGM, gsz = (nM - fm) < WGM ? (nM - fm) : WGM;
        u.pm = fm + ((wgid % nig) % gsz); u.pn = (wgid % nig) / gsz; return true;
    }
    __device__ __forceinline__ void a_ready(const Unit&) const {}
    __device__ __forceinline__ void done(const Unit&) const {}
};

__device__ __forceinline__ unsigned cvt_pk_bf16(float lo, float hi) { unsigned r; asm volatile("v_cvt_pk_bf16_f32 %0, %1, %2" : "=v"(r) : "v"(lo), "v"(hi)); return r; }
typedef float f32x2 __attribute__((ext_vector_type(2)));
__device__ __forceinline__ f32x2 gelu_pk(f32x2 v) {
    const f32x2 av = __builtin_elementwise_abs(v), d = av * 0.2316418882f + 1.0f;
    f32x2 t; t.x = __builtin_amdgcn_rcpf(d.x); t.y = __builtin_amdgcn_rcpf(d.y);
    f32x2 q = t * 0.5307027145f + (-0.7265760135f); q = q * t + 0.7107068705f; q = q * t + (-0.142248368f); q = q * t + 0.127414796f; q = q * t;
    const f32x2 s = (v * v) * (-0.72134752044f);
    f32x2 e; e.x = __builtin_amdgcn_exp2f(s.x); e.y = __builtin_amdgcn_exp2f(s.y);
    const f32x2 m = v * (q * e), r = v - m;
    f32x2 o; o.x = v.x < 0.f ? m.x : r.x; o.y = v.y < 0.f ? m.y : r.y; return o;
}

template <int ACT  > struct EpiBf16 {
    static constexpr bool PERM = true, AFTER_DRAIN = false; static_assert(ACT == 0 || ACT == 1, "EpiBf16: ACT is 0 (none) or 1 (gelu_pk)");
    bf16_t* O; int ldc; const float* bias; int split_cols; size_t split_stride; float scale0;
    __device__ __forceinline__ void operator()(const f32x4 (&acc)[2][2][4][2], const Unit& u, int wr, int wc, int fr, int fq) const {
        const int row0 = u.pm * BM + wr * 64 + fr; int colt = u.pn * BM; bf16_t* base = O;
        float sc = 1.f; if (split_cols) { const int t = colt / split_cols; base += (size_t)t * split_stride; colt -= t * split_cols; if (t == 0) sc = scale0; }
        const int col0 = colt + wc * 32 + 8 * fq, bcol0 = u.pn * BM + wc * 32 + 8 * fq;
        f32x4 bv[2][2];
#pragma unroll
        for (int bj = 0; bj < 2; ++bj)
#pragma unroll
            for (int n = 0; n < 2; ++n) bv[bj][n] = bias ? *(const f32x4*)(bias + bcol0 + bj * HALF + 4 * n) : (f32x4){0.f, 0.f, 0.f, 0.f};
#pragma unroll
        for (int ai = 0; ai < 2; ++ai)
#pragma unroll
            for (int m = 0; m < 4; ++m) { bf16_t* rowp = base + (size_t)(row0 + ai * HALF + m * 16) * ldc + col0;
#pragma unroll
                for (int bj = 0; bj < 2; ++bj) { f32x4 v0 = acc[ai][bj][m][0] + bv[bj][0], v1 = acc[ai][bj][m][1] + bv[bj][1];
                    if (ACT == 1) { f32x2 a = gelu_pk((f32x2){v0[0], v0[1]}), b = gelu_pk((f32x2){v0[2], v0[3]}), c = gelu_pk((f32x2){v1[0], v1[1]}), d = gelu_pk((f32x2){v1[2], v1[3]});
                        v0 = (f32x4){a.x, a.y, b.x, b.y}; v1 = (f32x4){c.x, c.y, d.x, d.y}; }
                    v0 = v0 * sc; v1 = v1 * sc; u32x4 w; w.x = cvt_pk_bf16(v0[0], v0[1]); w.y = cvt_pk_bf16(v0[2], v0[3]); w.z = cvt_pk_bf16(v1[0], v1[1]); w.w = cvt_pk_bf16(v1[2], v1[3]);
                    *(u32x4*)(rowp + bj * HALF) = w; } }
    }
};

struct PanelStats {
    unsigned* xbuf;
    unsigned* cnt;
    unsigned* tmo;
    int ntn; float eps;
    unsigned code;
    __device__ __forceinline__ bool run(const f32x4 (&v)[2][2][4][2], const Unit& u, int wr, int wc, int fr, int fq, PG8_LAS unsigned char* lds, int wid, int lane) const {
        typedef float f32x2v __attribute__((ext_vector_type(2)));
        PG8_LAS f32x2v* P = (PG8_LAS f32x2v*)lds;
        PG8_LAS f32x2v* S = (PG8_LAS f32x2v*)(lds + 8192);
        PG8_LAS unsigned* flag = (PG8_LAS unsigned*)(lds + 8192 + 2048);
#pragma unroll
        for (int ai = 0; ai < 2; ++ai)
#pragma unroll
            for (int m = 0; m < 4; ++m) {
                float s = 0.f;
#pragma unroll
                for (int bj = 0; bj < 2; ++bj)
#pragma unroll
                    for (int n = 0; n < 2; ++n) { const f32x4 x = v[ai][bj][m][n]; s += (x[0] + x[1]) + (x[2] + x[3]); }
                s += __shfl_xor(s, 16); s += __shfl_xor(s, 32);
                const float mw = s * (1.0f / 64.0f); float q = 0.f;
#pragma unroll
                for (int bj = 0; bj < 2; ++bj)
#pragma unroll
                    for (int n = 0; n < 2; ++n) { const f32x4 d = v[ai][bj][m][n] - mw; q += (d[0] * d[0] + d[1] * d[1]) + (d[2] * d[2] + d[3] * d[3]); }
                q += __shfl_xor(q, 16); q += __shfl_xor(q, 32);
                if (fq == 0) P[(ai * HALF + wr * 64 + m * 16 + fr) * 4 + wc] = (f32x2v){mw, q};
            }
        asm volatile("s_waitcnt lgkmcnt(0)" ::: "memory"); __builtin_amdgcn_s_barrier(); asm volatile("" ::: "memory");
#if defined(BROKEN_EXCHANGE_NO_WAIT)
#warning BROKEN CONTROL BUILD: the row-statistics exchange does not wait; results are wrong by design
        if (blockIdx.x >= 64) { const long long t0_ = clock64(); while (clock64() - t0_ < 60000) __builtin_amdgcn_s_sleep(8); }
#endif
        const int row = wid * 32 + (lane & 31);
        if (lane < 32) {
            const f32x2v a = P[row * 4 + 0], b = P[row * 4 + 1], c = P[row * 4 + 2], d = P[row * 4 + 3];
            const float mt = (a.x + b.x + c.x + d.x) * 0.25f;
            const float da = a.x - mt, db = b.x - mt, dc = c.x - mt, dd = d.x - mt;
            const float m2 = (a.y + b.y) + (c.y + d.y) + 64.0f * ((da * da + db * db) + (dc * dc + dd * dd));
            unsigned long long* slot = (unsigned long long*)xbuf + ((size_t)(u.pm * BM + row) * 4 + u.pn);
            __hip_atomic_store(slot, ((unsigned long long)__float_as_uint(m2) << 32) | __float_as_uint(mt), __ATOMIC_RELAXED, __HIP_MEMORY_SCOPE_AGENT);
        }
        asm volatile("s_waitcnt vmcnt(0)" ::: "memory");
        if (lane == 0) __hip_atomic_fetch_add(cnt + 64 * u.pm, 1u, __ATOMIC_RELAXED, __HIP_MEMORY_SCOPE_AGENT);
        if (wid == 0) {
            bool dead = false; const unsigned long long t0 = __builtin_amdgcn_s_memrealtime(); const unsigned want = 8u * (unsigned)ntn;
            for (;;) {
#if defined(BROKEN_EXCHANGE_NO_WAIT)
                break;
#endif
                if ((unsigned)__builtin_amdgcn_readfirstlane(__hip_atomic_load(cnt + 64 * u.pm, __ATOMIC_RELAXED, __HIP_MEMORY_SCOPE_AGENT)) >= want) break;
                if (__builtin_amdgcn_s_memrealtime() - t0 > 2000000ull) {
                    if (lane == 0) { unsigned expect = 0u; __hip_atomic_compare_exchange_strong(tmo + 1, &expect, code | (unsigned)(u.pm & 0xff), __ATOMIC_RELAXED, __ATOMIC_RELAXED, __HIP_MEMORY_SCOPE_AGENT);
                                     __hip_atomic_store(tmo, 1u, __ATOMIC_RELAXED, __HIP_MEMORY_SCOPE_AGENT); }
                    dead = true; break; }
                __builtin_amdgcn_s_sleep(2);
            }
            __builtin_amdgcn_fence(__ATOMIC_ACQUIRE, "agent");
            if (lane == 0) flag[0] = dead ? 1u : 0u;
        }
        asm volatile("s_waitcnt vmcnt(0) lgkmcnt(0)" ::: "memory"); __builtin_amdgcn_s_barrier(); asm volatile("" ::: "memory");
        const bool bad = flag[0] != 0u;
        if (lane < 32) {
            const unsigned long long* slot = (const unsigned long long*)xbuf + (size_t)(u.pm * BM + row) * 4; float mt[4], m2[4]; float ms = 0.f;
#pragma unroll
            for (int t = 0; t < 4; ++t) { if (t < ntn) { const unsigned long long w = __hip_atomic_load(slot + t, __ATOMIC_RELAXED, __HIP_MEMORY_SCOPE_AGENT); mt[t] = __uint_as_float((unsigned)w); m2[t] = __uint_as_float((unsigned)(w >> 32)); } else { mt[t] = 0.f; m2[t] = 0.f; } ms += mt[t]; }
            const float mean = ms / (float)ntn; float q = 0.f;
#pragma unroll
            for (int t = 0; t < 4; ++t) if (t < ntn) { const float dm = mt[t] - mean; q += m2[t] + 256.0f * dm * dm; }
            S[row] = (f32x2v){mean, 1.0f / sqrtf(q / (256.0f * (float)ntn) + eps)};
        }
        asm volatile("s_waitcnt lgkmcnt(0)" ::: "memory"); __builtin_amdgcn_s_barrier(); asm volatile("" ::: "memory");
        return bad;
    }
};
struct EpiLnRes {
    static constexpr bool PERM = false, AFTER_DRAIN = true;
    const float* base; float* out; int ldc; const float* bias; PanelStats st; unsigned poison;
    __device__ __forceinline__ void fused(f32x4 (&acc)[2][2][4][2], const Unit& u, int wr, int wc, int fr, int fq, PG8_LAS unsigned char* lds, int wid, int lane) const {
        typedef float f32x2v __attribute__((ext_vector_type(2)));
        const PG8_LAS f32x2v* S = (const PG8_LAS f32x2v*)(lds + 8192);
        const int col0 = u.pn * BM + wc * 32 + 4 * fq;
#pragma unroll
        for (int bj = 0; bj < 2; ++bj)
#pragma unroll
            for (int n = 0; n < 2; ++n) { const f32x4 bv = bias ? *(const f32x4*)(bias + col0 + bj * HALF + n * 16) : (f32x4){0.f, 0.f, 0.f, 0.f};
#pragma unroll
                for (int ai = 0; ai < 2; ++ai)
#pragma unroll
                    for (int m = 0; m < 4; ++m) acc[ai][bj][m][n] += bv; }
        f32x4 pre[4][2][2];
#pragma unroll
        for (int m = 0; m < 4; ++m) { const size_t off = (size_t)(u.pm * BM + wr * 64 + m * 16 + fr) * ldc + col0;
#pragma unroll
            for (int bj = 0; bj < 2; ++bj)
#pragma unroll
                for (int n = 0; n < 2; ++n) pre[m][bj][n] = *(const f32x4*)(base + off + bj * HALF + n * 16); }
        const bool bad = st.run(acc, u, wr, wc, fr, fq, lds, wid, lane) || poison != 0u;
        const float qnan = __builtin_nanf("");
#pragma unroll
        for (int ai = 0; ai < 2; ++ai)
#pragma unroll
            for (int m = 0; m < 4; ++m) { const int r = ai * HALF + wr * 64 + m * 16 + fr; const f32x2v sr = S[r]; const size_t off = (size_t)(u.pm * BM + r) * ldc + col0;
#pragma unroll
                for (int bj = 0; bj < 2; ++bj)
#pragma unroll
                    for (int n = 0; n < 2; ++n) { const f32x4 bs = ai == 0 ? pre[m][bj][n] : *(const f32x4*)(base + off + bj * HALF + n * 16); f32x4 o = bs + (acc[ai][bj][m][n] - sr.x) * sr.y;
                        if (bad) o = (f32x4){qnan, qnan, qnan, qnan}; *(f32x4*)(out + off + bj * HALF + n * 16) = o; }
                if (m & 1) asm volatile("" ::: "memory"); }
    }
};
struct EpiLnResLn {
    static constexpr bool PERM = false, AFTER_DRAIN = true;
    const float* base; float* out; bf16_t* xn; int ldc; const float* bias; PanelStats st1, st2; unsigned poison;
    __device__ __forceinline__ void fused(f32x4 (&acc)[2][2][4][2], const Unit& u, int wr, int wc, int fr, int fq, PG8_LAS unsigned char* lds, int wid, int lane) const {
        typedef float f32x2v __attribute__((ext_vector_type(2))); typedef unsigned u32x2v __attribute__((ext_vector_type(2)));
        const PG8_LAS f32x2v* S = (const PG8_LAS f32x2v*)(lds + 8192);
        const int col0 = u.pn * BM + wc * 32 + 4 * fq;
#pragma unroll
        for (int bj = 0; bj < 2; ++bj)
#pragma unroll
            for (int n = 0; n < 2; ++n) { const f32x4 bv = bias ? *(const f32x4*)(bias + col0 + bj * HALF + n * 16) : (f32x4){0.f, 0.f, 0.f, 0.f};
#pragma unroll
                for (int ai = 0; ai < 2; ++ai)
#pragma unroll
                    for (int m = 0; m < 4; ++m) acc[ai][bj][m][n] += bv; }
        bool bad = st1.run(acc, u, wr, wc, fr, fq, lds, wid, lane) || poison != 0u;
        const float qnan = __builtin_nanf("");
#pragma unroll
        for (int ai = 0; ai < 2; ++ai)
#pragma unroll
            for (int m = 0; m < 4; ++m) { const int r = ai * HALF + wr * 64 + m * 16 + fr; const f32x2v sr = S[r]; const size_t off = (size_t)(u.pm * BM + r) * ldc + col0;
#pragma unroll
                for (int bj = 0; bj < 2; ++bj)
#pragma unroll
                    for (int n = 0; n < 2; ++n) { const f32x4 bs = *(const f32x4*)(base + off + bj * HALF + n * 16); acc[ai][bj][m][n] = bs + (acc[ai][bj][m][n] - sr.x) * sr.y; }
                asm volatile("" : "+v"(acc[ai][0][m][0]), "+v"(acc[ai][0][m][1]), "+v"(acc[ai][1][m][0]), "+v"(acc[ai][1][m][1]));
                if (m & 1) asm volatile("" ::: "memory"); }
        const bool bad1 = bad;
        bad = st2.run(acc, u, wr, wc, fr, fq, lds, wid, lane) || bad;
#pragma unroll
        for (int ai = 0; ai < 2; ++ai)
#pragma unroll
            for (int m = 0; m < 4; ++m) { const int r = ai * HALF + wr * 64 + m * 16 + fr; const f32x2v sr = S[r]; const size_t off = (size_t)(u.pm * BM + r) * ldc + col0;
#pragma unroll
                for (int bj = 0; bj < 2; ++bj)
#pragma unroll
                    for (int n = 0; n < 2; ++n) { const f32x4 x1 = acc[ai][bj][m][n]; *(f32x4*)(out + off + bj * HALF + n * 16) = bad1 ? (f32x4){qnan, qnan, qnan, qnan} : x1;
                        const f32x4 o = (x1 - sr.x) * sr.y; u32x2v w; w.x = cvt_pk_bf16(o[0], o[1]); w.y = cvt_pk_bf16(o[2], o[3]);
                        if (bad) { w.x = 0x7fc07fc0u; w.y = 0x7fc07fc0u; } *(u32x2v*)(xn + off + bj * HALF + n * 16) = w; }
                asm volatile("" ::: "memory"); }
    }
};

template <class Epi, class Sched, bool ALIGN_EPI = false, bool SP2 = false>
__device__ __forceinline__ void gemm_phase(PG8_LAS unsigned char* lds, const Gemm g, const Sched& S, const Epi& E) {
    const int tid = threadIdx.x, wid = __builtin_amdgcn_readfirstlane(tid >> 6), lane = tid & 63, wr = wid >> 2, wc = wid & 3, fr = lane & 15, fq = lane >> 4;
    const int K = g.K, nt = K / BK;
    unsigned voffA[2], voffB[2];
#pragma unroll
    for (int i = 0; i < 2; ++i) { int R, C; stage_rc(tid * 16 + i * 8192, R, C); const int Rb = Epi::PERM ? ((R & ~31) + perm32(R & 31)) : R;
        voffA[i] = (unsigned)(R * K + C) * 2u; voffB[i] = (unsigned)(Rb * K + C) * 2u; }
    const size_t kstep = (size_t)(BK * 2);
    const size_t hstep = (size_t)HALF * K * 2;
    const size_t tstep = 2 * hstep;
    const unsigned ldsw = (unsigned)wid * 1024u;
    const int aoff = lds_byte(wr * 64 + fr, fq * 8), boff = lds_byte(wc * 32 + fr, fq * 8);
#define PG8_SA(b, h) (((b) * 2 + (h)) * HTB)
#define PG8_SB(b, h) ((4 + (b) * 2 + (h)) * HTB)
#define PG8_STAGE(bufoff, gbase, voff) do { _Pragma("unroll") for (int _i = 0; _i < 2; ++_i) \
        __builtin_amdgcn_global_load_lds((const unsigned*)((const char*)(gbase) + (voff)[_i]), (PG8_LAS unsigned*)(lds + (bufoff) + ldsw + _i * 8192), 16, 0, 0); } while (0)
#define PG8_LDA(dst, b, h) do { _Pragma("unroll") for (int m = 0; m < 4; ++m) _Pragma("unroll") for (int k = 0; k < 2; ++k) dst[m][k] = *(const PG8_LAS bf16x8*)(lds + PG8_SA(b, h) + aoff + m * 2048 + k * 1024); } while (0)
#define PG8_LDB(dst, b, h) do { _Pragma("unroll") for (int n = 0; n < 2; ++n) _Pragma("unroll") for (int k = 0; k < 2; ++k) dst[n][k] = *(const PG8_LAS bf16x8*)(lds + PG8_SB(b, h) + boff + n * 2048 + k * 1024); } while (0)
#define PG8_MMA(ai, bj, At, Bt) do { __builtin_amdgcn_s_setprio(1); _Pragma("unroll") for (int m = 0; m < 4; ++m) _Pragma("unroll") for (int n = 0; n < 2; ++n) _Pragma("unroll") for (int k = 0; k < 2; ++k) \
        acc[ai][bj][m][n] = __builtin_amdgcn_mfma_f32_16x16x32_bf16(Bt[n][k], At[m][k], acc[ai][bj][m][n], 0, 0, 0); __builtin_amdgcn_s_setprio(0); } while (0)
#define PG8_WAIT_V(n) asm volatile("s_waitcnt vmcnt(" #n ")" ::: "memory")
#define PG8_WAIT_L(n) asm volatile("s_waitcnt lgkmcnt(" #n ")" ::: "memory")
#define PG8_BAR __builtin_amdgcn_s_barrier()
#define PG8_SCHED __builtin_amdgcn_sched_barrier(0)
    Unit cur, nxt; int ui = 0;
    if (!S.next(0, cur)) return;
    f32x4 acc[2][2][4][2];
#pragma unroll
    for (int a = 0; a < 2; ++a)
#pragma unroll
        for (int b = 0; b < 2; ++b)
#pragma unroll
            for (int m = 0; m < 4; ++m)
#pragma unroll
                for (int n = 0; n < 2; ++n) acc[a][b][m][n] = (f32x4){0.f, 0.f, 0.f, 0.f};
    bf16x8 At[4][2], B0[2][2], B1[2][2];
    const char* cA = (const char*)g.A + (size_t)cur.pm * tstep; const char* cB = (const char*)g.Bt + (size_t)cur.pn * tstep;
    S.a_ready(cur);
    if constexpr (SP2) {
        PG8_STAGE(PG8_SB(0, 0), cB, voffB); PG8_STAGE(PG8_SB(0, 1), cB + hstep, voffB); PG8_STAGE(PG8_SA(0, 0), cA, voffA); PG8_STAGE(PG8_SA(0, 1), cA + hstep, voffA);
        if (wr == 1) PG8_BAR;
        PG8_WAIT_V(2); PG8_BAR;
        PG8_STAGE(PG8_SB(1, 0), cB + kstep, voffB); PG8_STAGE(PG8_SA(1, 0), cA + kstep, voffA); PG8_STAGE(PG8_SB(1, 1), cB + hstep + kstep, voffB);
        PG8_WAIT_V(6); PG8_BAR;
    } else {
        PG8_STAGE(PG8_SB(0, 0), cB, voffB); PG8_STAGE(PG8_SA(0, 0), cA, voffA); PG8_STAGE(PG8_SB(0, 1), cB + hstep, voffB); PG8_STAGE(PG8_SA(0, 1), cA + hstep, voffA);
        if (wr == 1) PG8_BAR;
        PG8_WAIT_V(4); PG8_BAR;
        PG8_STAGE(PG8_SB(1, 0), cB + kstep, voffB); PG8_STAGE(PG8_SA(1, 0), cA + kstep, voffA); PG8_STAGE(PG8_SB(1, 1), cB + hstep + kstep, voffB);
        PG8_WAIT_V(6); PG8_BAR;
    }
    for (;;) {
        const bool has_next = S.next(ui + 1, nxt);
        const char* nA = has_next ? (const char*)g.A + (size_t)nxt.pm * tstep : cA; const char* nB = has_next ? (const char*)g.Bt + (size_t)nxt.pn * tstep : cB;
        for (int t = 0; t < nt; t += 2) {
            const bool last = (t == nt - 2);
            const char* a1 = cA + (size_t)(t + 1) * kstep;
            const char* a2 = last ? nA : cA + (size_t)(t + 2) * kstep; const char* b2 = last ? nB : cB + (size_t)(t + 2) * kstep;
            const char* a3 = a2 + kstep; const char* b3 = b2 + kstep;
            if (last && has_next) S.a_ready(nxt);
            if constexpr (SP2) {
            PG8_LDB(B0, 0, 0); PG8_LDB(B1, 0, 1); PG8_SCHED; PG8_LDA(At, 0, 0); PG8_STAGE(PG8_SA(1, 1), a1 + hstep, voffA);
            PG8_WAIT_V(8); PG8_WAIT_L(0); PG8_BAR; PG8_MMA(0, 0, At, B0); PG8_MMA(0, 1, At, B1); PG8_BAR; PG8_SCHED;
            PG8_LDA(At, 0, 1); PG8_STAGE(PG8_SB(0, 0), b2, voffB); PG8_STAGE(PG8_SB(0, 1), b2 + hstep, voffB); PG8_STAGE(PG8_SA(0, 0), a2, voffA);
            PG8_WAIT_V(8); PG8_WAIT_L(0); PG8_BAR; PG8_MMA(1, 0, At, B0); PG8_MMA(1, 1, At, B1); PG8_BAR; PG8_SCHED;
            PG8_LDB(B0, 1, 0); PG8_LDB(B1, 1, 1); PG8_SCHED; PG8_LDA(At, 1, 0); PG8_STAGE(PG8_SA(0, 1), a2 + hstep, voffA);
            PG8_WAIT_V(8); PG8_WAIT_L(0); PG8_BAR; PG8_MMA(0, 0, At, B0); PG8_MMA(0, 1, At, B1); PG8_BAR; PG8_SCHED;
            PG8_LDA(At, 1, 1); PG8_STAGE(PG8_SB(1, 0), b3, voffB); PG8_STAGE(PG8_SB(1, 1), b3 + hstep, voffB); PG8_STAGE(PG8_SA(1, 0), a3, voffA);
            PG8_WAIT_V(8); PG8_WAIT_L(0); PG8_BAR; PG8_MMA(1, 0, At, B0); PG8_MMA(1, 1, At, B1); PG8_BAR; PG8_SCHED;
            } else {
            PG8_LDB(B0, 0, 0); PG8_SCHED; PG8_LDA(At, 0, 0); PG8_STAGE(PG8_SA(1, 1), a1 + hstep, voffA);
            PG8_WAIT_L(8); PG8_BAR; PG8_WAIT_L(0); PG8_MMA(0, 0, At, B0); PG8_BAR; PG8_SCHED;
            PG8_LDB(B1, 0, 1); PG8_STAGE(PG8_SB(0, 0), b2, voffB);
            PG8_BAR; PG8_WAIT_L(0); PG8_MMA(0, 1, At, B1); PG8_BAR;
            PG8_LDA(At, 0, 1); PG8_STAGE(PG8_SA(0, 0), a2, voffA);
            PG8_BAR; PG8_WAIT_L(0); PG8_MMA(1, 0, At, B0); PG8_BAR; PG8_SCHED;
            PG8_STAGE(PG8_SB(0, 1), b2 + hstep, voffB);
            PG8_WAIT_V(6); PG8_BAR; PG8_MMA(1, 1, At, B1); PG8_BAR;
            PG8_LDB(B0, 1, 0); PG8_SCHED; PG8_LDA(At, 1, 0); PG8_STAGE(PG8_SA(0, 1), a2 + hstep, voffA);
            PG8_WAIT_L(8); PG8_BAR; PG8_WAIT_L(0); PG8_MMA(0, 0, At, B0); PG8_BAR; PG8_SCHED;
            PG8_LDB(B1, 1, 1); PG8_STAGE(PG8_SB(1, 0), b3, voffB);
            PG8_BAR; PG8_WAIT_L(0); PG8_MMA(0, 1, At, B1); PG8_BAR;
            PG8_LDA(At, 1, 1); PG8_STAGE(PG8_SA(1, 0), a3, voffA);
            PG8_BAR; PG8_WAIT_L(0); PG8_MMA(1, 0, At, B0); PG8_BAR; PG8_SCHED;
            PG8_STAGE(PG8_SB(1, 1), b3 + hstep, voffB);
            PG8_WAIT_V(6); PG8_BAR; PG8_MMA(1, 1, At, B1); PG8_BAR;
            }
        }
        if constexpr (ALIGN_EPI) { if (wr == 0) PG8_BAR; }
        if constexpr (!Epi::AFTER_DRAIN) { E(acc, cur, wr, wc, fr, fq); S.done(cur); }
        if (!has_next) break;
#pragma unroll
        for (int a = 0; a < 2; ++a)
#pragma unroll
            for (int b = 0; b < 2; ++b)
#pragma unroll
                for (int m = 0; m < 4; ++m)
#pragma unroll
                    for (int n = 0; n < 2; ++n) acc[a][b][m][n] = (f32x4){0.f, 0.f, 0.f, 0.f};
        cur = nxt; cA = nA; cB = nB; ++ui;
        if constexpr (ALIGN_EPI) { if (wr == 1) PG8_BAR; }
    }
    PG8_WAIT_V(0);
    if constexpr (!ALIGN_EPI) { if (wr == 0) PG8_BAR; }
    PG8_BAR;
    if constexpr (Epi::AFTER_DRAIN) { E.fused(acc, cur, wr, wc, fr, fq, lds, wid, lane); S.done(cur); }
#undef PG8_SA
#undef PG8_SB
#undef PG8_STAGE
#undef PG8_LDA
#undef PG8_LDB
#undef PG8_MMA
#undef PG8_WAIT_V
#undef PG8_WAIT_L
#undef PG8_BAR
#undef PG8_SCHED
}
}
#define LAS __attribute__((address_space(3)))
typedef unsigned short bf16;
typedef unsigned v4u __attribute__((ext_vector_type(4)));
typedef unsigned v2u __attribute__((ext_vector_type(2)));
typedef float f32x4 __attribute__((ext_vector_type(4)));
using pg8::bf16_t;

constexpr int NWAVES = 8, NT = 512;
constexpr int BATCH = 8, SEQ = 2048, M = BATCH * SEQ, D = 1024, DIN = 2048, DFF = 2816, PLE = 256;
constexpr float ALPHA = 1.4142135623730951f, LN_EPS = 1e-5f;
constexpr int N_PHASES = 17;
#ifndef MK_PER_PHASE
#define MK_PER_PHASE 0
#endif

constexpr size_t MiB = 1u << 20;
constexpr size_t WS_WIN = 1 * MiB, WS_WOUT = 9 * MiB, WS_WGU = 13 * MiB, WS_WD = 35 * MiB, WS_WPG = 46 * MiB, WS_WPP = 50 * MiB;
constexpr size_t WS_XB = 52 * MiB, WS_PP = 84 * MiB, WS_H = 148 * MiB, WS_MIX = 212 * MiB, WS_HFF = 148 * MiB, WS_END = 244 * MiB;
constexpr int LDS_BYTES = 135168;

#define LDS_WAIT() asm volatile("s_waitcnt lgkmcnt(0)" ::: "memory")
__device__ __forceinline__ unsigned f2bf(float f) { unsigned u = __builtin_bit_cast(unsigned, f); return (u + 0x7fffu + ((u >> 16) & 1u)) >> 16; }
__device__ __forceinline__ unsigned pk2(float lo, float hi) { return f2bf(lo) | (f2bf(hi) << 16); }
__device__ __forceinline__ float bf2f(bf16 v) { return __builtin_bit_cast(float, (unsigned)v << 16); }
__device__ __forceinline__ float bflo(unsigned w) { return __builtin_bit_cast(float, w << 16); }
__device__ __forceinline__ float bfhi(unsigned w) { return __builtin_bit_cast(float, w & 0xffff0000u); }
__device__ __forceinline__ float rl(float v, int l) { return __builtin_bit_cast(float, __builtin_amdgcn_readlane(__builtin_bit_cast(int, v), l)); }
__device__ __forceinline__ float fast_exp(float x) { return __builtin_amdgcn_exp2f(x * 1.4426950408889634f); }
__device__ __forceinline__ float sigmoidf_(float x) { return __builtin_amdgcn_rcpf(1.0f + fast_exp(-x)); }
__device__ __forceinline__ float siluf_(float x) { return x * sigmoidf_(x); }
__device__ __forceinline__ float softplusf_(float z) { return fmaxf(z, 0.f) + 0.6931471805599453f * __builtin_amdgcn_logf(1.0f + fast_exp(-fabsf(z))); }
__device__ __forceinline__ float gelu_tanh(float x) { const float y2 = 1.5957691216057308f * (x + 0.044715f * x * x * x); return x * sigmoidf_(y2); }
__device__ __forceinline__ float wave_sum(float v) {
#pragma unroll
    for (int o = 1; o < 64; o <<= 1) v += __shfl_xor(v, o);
    return v;
}

using pg8::Unit; using pg8::HALF; using pg8::BM;
struct EpiSwiglu {
    static constexpr bool PERM = true, AFTER_DRAIN = false;
    bf16_t* O; int ldc;
    __device__ __forceinline__ void operator()(const pg8::f32x4 (&acc)[2][2][4][2], const Unit& u, int wr, int wc, int fr, int fq) const {
        const int row0 = u.pm * BM + wr * 64 + fr, col0 = u.pn * HALF + wc * 32 + 8 * fq;
#pragma unroll
        for (int ai = 0; ai < 2; ++ai)
#pragma unroll
            for (int m = 0; m < 4; ++m) {
                bf16_t* rowp = O + (size_t)(row0 + ai * HALF + m * 16) * ldc + col0;
                const pg8::f32x4 g0 = acc[ai][0][m][0], g1 = acc[ai][0][m][1], u0 = acc[ai][1][m][0], u1 = acc[ai][1][m][1];
                pg8::u32x4 w;
                w.x = pg8::cvt_pk_bf16(siluf_(g0[0]) * u0[0], siluf_(g0[1]) * u0[1]); w.y = pg8::cvt_pk_bf16(siluf_(g0[2]) * u0[2], siluf_(g0[3]) * u0[3]);
                w.z = pg8::cvt_pk_bf16(siluf_(g1[0]) * u1[0], siluf_(g1[1]) * u1[1]); w.w = pg8::cvt_pk_bf16(siluf_(g1[2]) * u1[2], siluf_(g1[3]) * u1[3]);
                *(pg8::u32x4*)rowp = w;
            }
    }
};
struct EpiResid {
    static constexpr bool PERM = false, AFTER_DRAIN = false;
    const float* base; float* out; int ldc; float alpha;
    __device__ __forceinline__ void operator()(const pg8::f32x4 (&acc)[2][2][4][2], const Unit& u, int wr, int wc, int fr, int fq) const {
        const int col0 = u.pn * BM + wc * 32 + 4 * fq;
#pragma unroll
        for (int ai = 0; ai < 2; ++ai)
#pragma unroll
            for (int m = 0; m < 4; ++m) {
                const size_t off = (size_t)(u.pm * BM + ai * HALF + wr * 64 + m * 16 + fr) * ldc + col0;
#pragma unroll
                for (int bj = 0; bj < 2; ++bj)
#pragma unroll
                    for (int n = 0; n < 2; ++n) { const size_t o = off + bj * HALF + n * 16; const pg8::f32x4 bs = *(const pg8::f32x4*)(base + o); *(pg8::f32x4*)(out + o) = bs * alpha + acc[ai][bj][m][n]; }
                asm volatile("" ::: "memory");
            }
    }
};
struct EpiPle {
    static constexpr bool PERM = false, AFTER_DRAIN = false;
    const float* bias; const bf16_t* pp; float* xf; bf16_t* xb;
    __device__ __forceinline__ void operator()(const pg8::f32x4 (&acc)[2][2][4][2], const Unit& u, int wr, int wc, int fr, int fq) const {
        const int col0 = u.pn * BM + wc * 32 + 4 * fq;
        pg8::f32x4 bv[2][2];
#pragma unroll
        for (int bj = 0; bj < 2; ++bj)
#pragma unroll
            for (int n = 0; n < 2; ++n) bv[bj][n] = *(const pg8::f32x4*)(bias + col0 + bj * HALF + n * 16);
#pragma unroll
        for (int ai = 0; ai < 2; ++ai)
#pragma unroll
            for (int m = 0; m < 4; ++m) {
                const size_t off = (size_t)(u.pm * BM + ai * HALF + wr * 64 + m * 16 + fr) * D + col0;
#pragma unroll
                for (int bj = 0; bj < 2; ++bj)
#pragma unroll
                    for (int n = 0; n < 2; ++n) {
                        const size_t o = off + bj * HALF + n * 16;
                        const pg8::f32x4 x2 = *(const pg8::f32x4*)(xf + o); const v2u pw = *(const v2u*)(pp + o);
                        const pg8::f32x4 a = acc[ai][bj][m][n] + bv[bj][n];
                        pg8::f32x4 r;
                        r[0] = x2[0] + sigmoidf_(a[0]) * bflo(pw.x); r[1] = x2[1] + sigmoidf_(a[1]) * bfhi(pw.x);
                        r[2] = x2[2] + sigmoidf_(a[2]) * bflo(pw.y); r[3] = x2[3] + sigmoidf_(a[3]) * bfhi(pw.y);
                        *(pg8::f32x4*)(xf + o) = r;
                        if (xb) { v2u w; w.x = pg8::cvt_pk_bf16(r[0], r[1]); w.y = pg8::cvt_pk_bf16(r[2], r[3]); *(v2u*)(xb + o) = w; }
                    }
                asm volatile("" ::: "memory");
            }
    }
};

template <class Epi>
__device__ __forceinline__ void run_gemm(LAS unsigned char* lds, const bf16_t* A, const bf16_t* Bt, int N, int K, const Epi& E, int G, int bid) {
    int zq = 0; asm volatile("s_mov_b32 %0, 0" : "=s"(zq));
    K += zq; N += zq;
    pg8::Gemm g{A, Bt, M, N, K}; pg8::StaticOrder S; S.init(M, N, G, bid);
    pg8::gemm_phase<Epi, pg8::StaticOrder, true, true>(lds, g, S, E);
}

__device__ __forceinline__ void transpose_item(const float* W, int K, int N, bf16* WT, int kb, int n0, int dst_row0, LAS float* scr, int lane) {
    const int k0 = 64 * kb;
#pragma unroll 8
    for (int i = 0; i < 32; ++i) { const int kk = 2 * i + (lane >> 5); scr[kk * 33 + (lane & 31)] = W[(size_t)(k0 + kk) * N + n0 + (lane & 31)]; }
    LDS_WAIT();
    const int c = lane & 7;
#pragma unroll
    for (int j = 0; j < 4; ++j) { const int n = (lane >> 3) + 8 * j; const LAS float* s = scr + (8 * c) * 33 + n;
        v4u o; o.x = pk2(s[0 * 33], s[1 * 33]); o.y = pk2(s[2 * 33], s[3 * 33]); o.z = pk2(s[4 * 33], s[5 * 33]); o.w = pk2(s[6 * 33], s[7 * 33]);
        *(v4u*)(WT + (size_t)(dst_row0 + n) * K + k0 + 8 * c) = o; }
    LDS_WAIT();
}
__device__ __forceinline__ void cvt_f32_bf16(const float* src, bf16* dst, size_t n8, size_t gtid, size_t gthreads) {
    for (size_t i = gtid; i < n8; i += gthreads) {
        const f32x4 a = ((const f32x4*)src)[2 * i], b = ((const f32x4*)src)[2 * i + 1];
        v4u o; o.x = pk2(a[0], a[1]); o.y = pk2(a[2], a[3]); o.z = pk2(b[0], b[1]); o.w = pk2(b[2], b[3]);
        ((v4u*)dst)[i] = o;
    }
}
__device__ __forceinline__ void ln_phase(float* buf, bf16* xb, const float* g, const float* b, int gw, int NGW, int lane) {
    for (int m = gw; m < M; m += NGW) {
        f32x4* xr = (f32x4*)(buf + (size_t)m * D) + lane;
        f32x4 v[4]; float s = 0.f;
#pragma unroll
        for (int j = 0; j < 4; ++j) { v[j] = xr[64 * j]; s += (v[j][0] + v[j][1]) + (v[j][2] + v[j][3]); }
        const float mean = wave_sum(s) * (1.f / D); float s2 = 0.f;
#pragma unroll
        for (int j = 0; j < 4; ++j) { v[j] = v[j] - mean; s2 += (v[j][0] * v[j][0] + v[j][1] * v[j][1]) + (v[j][2] * v[j][2] + v[j][3] * v[j][3]); }
        const float rstd = 1.f / sqrtf(wave_sum(s2) * (1.f / D) + LN_EPS);
        v2u* o8 = (v2u*)(xb + (size_t)m * D) + lane;
#pragma unroll
        for (int j = 0; j < 4; ++j) {
            const f32x4 gg = ((const f32x4*)g)[lane + 64 * j], bb = ((const f32x4*)b)[lane + 64 * j];
            const f32x4 o = v[j] * rstd * gg + bb;
            xr[64 * j] = o; v2u w; w.x = pk2(o[0], o[1]); w.y = pk2(o[2], o[3]); o8[64 * j] = w;
        }
    }
}

__device__ __forceinline__ void attn_simple(const bf16* Hb, bf16* MIX, int gw, int NGW, int lane) {
    for (int item = gw; item < BATCH * 8 * SEQ; item += NGW) {
        const int t = item & (SEQ - 1), bh = item >> 11, b = bh >> 3, h = bh & 7;
        const bf16* base = Hb + (size_t)b * SEQ * DIN + h * 64;
        const float qv = bf2f(base[(size_t)t * DIN + lane]) * 0.125f;
        float o = 0.f, carry = 0.f;
        for (int hi = t; hi > 0; hi -= 64) {
            const int s = hi - 64 + lane; const bool valid = s >= 0; const int sc = valid ? s : 0;
            const bf16* krow = base + (size_t)sc * DIN + 512;
            float z = 0.f;
#pragma unroll
            for (int i = 0; i < 8; ++i) { const v4u kk = *(const v4u*)(krow + 8 * i);
                z += rl(qv, 8 * i + 0) * bflo(kk.x); z += rl(qv, 8 * i + 1) * bfhi(kk.x); z += rl(qv, 8 * i + 2) * bflo(kk.y); z += rl(qv, 8 * i + 3) * bfhi(kk.y);
                z += rl(qv, 8 * i + 4) * bflo(kk.z); z += rl(qv, 8 * i + 5) * bfhi(kk.z); z += rl(qv, 8 * i + 6) * bflo(kk.w); z += rl(qv, 8 * i + 7) * bfhi(kk.w); }
            const float L = valid ? -softplusf_(z) : 0.f;
            float R = L;
#pragma unroll
            for (int off = 1; off < 64; off <<= 1) { const float tmp = __shfl_down(R, off); if (lane + off < 64) R += tmp; }
            const float tot = rl(R, 0);
            const float w = valid ? fast_exp(z + R + carry) : 0.f;
            carry += tot;
#pragma unroll 16
            for (int j = 0; j < 64; ++j) { const float wj = __shfl(w, j); int sj = hi - 64 + j; sj = sj < 0 ? 0 : sj;
                o += wj * bf2f(base[(size_t)sj * DIN + 1024 + lane]); }
            if (carry < -110.f) break;
        }
        MIX[((size_t)b * SEQ + t) * D + h * 64 + lane] = (bf16)f2bf(o);
    }
}
__device__ __forceinline__ void pool_simple(const bf16* Hb, bf16* MIX, const float* pool_w, const float* pool_scale, LAS float* P, int bid, int G, int tid) {
    for (int unit = bid; unit < (M / 32) * 4; unit += G) {
        const int g = unit & 3, row0 = (unit >> 2) * 32, t0 = row0 & (SEQ - 1), w = 2 << g;
        for (int e = tid; e < 32 * 128; e += NT) {
            const int r = e >> 7, c = e & 127, t = t0 + r;
            const bf16* up = Hb + (size_t)(row0 + r) * DIN + 1536 + g * 128 + c;
            float sum = 0.f;
            for (int j = 0; j < w; ++j) if (t - j >= 0) sum += bf2f(*(up - (size_t)j * DIN));
            const int cnt = (t + 1) < w ? (t + 1) : w;
            P[r * 128 + c] = sum / (float)cnt - bf2f(*up);
        }
        __syncthreads();
        const int d = tid & 127, rq = tid >> 7;
        float acc[8];
#pragma unroll
        for (int i = 0; i < 8; ++i) acc[i] = 0.f;
        const float* wp = pool_w + (size_t)g * 128 * 128 + d;
        for (int c = 0; c < 128; ++c) { const float wv = wp[(size_t)c * 128];
#pragma unroll
            for (int i = 0; i < 8; ++i) acc[i] += P[(rq * 8 + i) * 128 + c] * wv; }
        const float sc = pool_scale[g * 128 + d];
#pragma unroll
        for (int i = 0; i < 8; ++i) MIX[(size_t)(row0 + rq * 8 + i) * D + 512 + g * 128 + d] = (bf16)f2bf(acc[i] * sc);
        __syncthreads();
    }
}
__device__ __forceinline__ void conv_simple(const bf16* Hb, bf16* MIX, const float* dw, const float* ln_g, const float* ln_b, LAS float* hh, int bid, int G, int tid, int wave, int lane) {
    for (int unit = bid; unit < M / 32; unit += G) {
        const int row0 = unit * 32, t0 = row0 & (SEQ - 1);
        for (int e = tid; e < 62 * 512; e += NT) {
            const int r = e >> 9, c = e & 511, t = t0 - 30 + r;
            float val = 0.f;
            if (t >= 0) { const bf16* p = Hb + (size_t)(row0 - 30 + r) * DIN + c; val = bf2f(p[0]) * sigmoidf_(bf2f(p[512])); }
            hh[r * 512 + c] = val;
        }
        __syncthreads();
        {
            const int c = tid;
            float wk[31];
#pragma unroll
            for (int k = 0; k < 31; ++k) wk[k] = dw[k * 512 + c];
            for (int i = 0; i < 32; ++i) {
                float y = 0.f;
#pragma unroll
                for (int k = 0; k < 31; ++k) y += wk[k] * hh[(i + k) * 512 + c];
                hh[i * 512 + c] = y;
            }
        }
        __syncthreads();
        for (int i = wave * 4; i < wave * 4 + 4; ++i) {
            float v[8]; float s = 0.f;
#pragma unroll
            for (int j = 0; j < 8; ++j) { v[j] = hh[i * 512 + lane + 64 * j]; s += v[j]; }
            const float mean = wave_sum(s) * (1.f / 512.f); float s2 = 0.f;
#pragma unroll
            for (int j = 0; j < 8; ++j) { v[j] -= mean; s2 += v[j] * v[j]; }
            const float rstd = 1.f / sqrtf(wave_sum(s2) * (1.f / 512.f) + LN_EPS);
#pragma unroll
            for (int j = 0; j < 8; ++j) { const int c = lane + 64 * j; const float y = v[j] * rstd * ln_g[c] + ln_b[c];
                MIX[(size_t)(row0 + i) * D + c] = (bf16)f2bf(siluf_(y)); }
        }
        __syncthreads();
    }
}
__device__ __forceinline__ void sg_simple(const bf16* Hb, bf16* MIX, const float* ln_g, const float* ln_b, const float* sg_w, const float* sg_b, LAS float* V, LAS float* ST,
                                          int bid, int G, int tid, int wave, int lane) {
    for (int unit = bid; unit < (M / 128) * 4; unit += G) {
        const int g = unit & 3, row0 = (unit >> 2) * 128;
        for (int r = wave * 16; r < wave * 16 + 16; ++r) {
            const bf16* vp = Hb + (size_t)(row0 + r) * DIN + 1536;
            float v[8]; float s = 0.f;
#pragma unroll
            for (int j = 0; j < 8; ++j) { v[j] = gelu_tanh(bf2f(vp[lane + 64 * j])); s += v[j]; }
            const float mean = wave_sum(s) * (1.f / 512.f); float s2 = 0.f;
#pragma unroll
            for (int j = 0; j < 8; ++j) { const float dlt = v[j] - mean; s2 += dlt * dlt; }
            const float rstd = 1.f / sqrtf(wave_sum(s2) * (1.f / 512.f) + LN_EPS);
            if (lane == 0) { ST[2 * r] = mean; ST[2 * r + 1] = rstd; }
        }
        __syncthreads();
        for (int e = tid; e < 128 * 128; e += NT) {
            const int s = e >> 7, d = e & 127, c = g * 128 + d;
            const float v = gelu_tanh(bf2f(Hb[(size_t)(row0 + s) * DIN + 1536 + c]));
            V[s * 128 + d] = (v - ST[2 * s]) * ST[2 * s + 1] * ln_g[c] + ln_b[c];
        }
        __syncthreads();
        {
            const int d = tid & 127, tq = tid >> 7;
            for (int i = 0; i < 32; ++i) {
                const int t = tq + 4 * i;
                const float* wrow = sg_w + ((size_t)g * 128 + t) * 128;
                float acc = 0.f;
                for (int s = 0; s <= t; ++s) acc += wrow[s] * V[s * 128 + d];
                const float sv = acc + sg_b[g * 128 + t];
                const float uu = gelu_tanh(bf2f(Hb[(size_t)(row0 + t) * DIN + 1024 + g * 128 + d]));
                MIX[(size_t)(row0 + t) * D + 512 + g * 128 + d] = (bf16)f2bf(uu * sv);
            }
        }
        __syncthreads();
    }
}

struct Args { const float* in[25]; float* out; unsigned char* ws; int ph_lo, ph_hi; };
__global__ void __launch_bounds__(NT, 2) mega_fwd(Args args) {
    extern __shared__ __attribute__((aligned(16))) unsigned char lds_raw[];
    cg::grid_group grid = cg::this_grid();
    LAS unsigned char* lds = (LAS unsigned char*)lds_raw;
    const int tid = threadIdx.x, lane = tid & 63, wave = __builtin_amdgcn_readfirstlane(tid >> 6);
    const int G = gridDim.x, bid = blockIdx.x;
    const int gw = bid * NWAVES + wave, NGW = G * NWAVES;
    const int lo = args.ph_lo, hi = args.ph_hi;
    unsigned char* ws = args.ws;
    bf16* XB = (bf16*)(ws + WS_XB); bf16* PP = (bf16*)(ws + WS_PP); bf16* Hb = (bf16*)(ws + WS_H); bf16* MIX = (bf16*)(ws + WS_MIX); bf16* HFF = (bf16*)(ws + WS_HFF);
    bf16* PB = (bf16*)args.out;
    float* XF = args.out;
#ifndef DIS_MASK
#define DIS_MASK 0
#endif
#define RUN(k) (lo <= (k) && (k) < hi)
#define RUNJ(j) (!((DIS_MASK >> (j)) & 1) && RUN(pb + (j)))
#define SEAM(k) do { if (lo <= (k) && (k) + 1 < hi) grid.sync(); } while (0)

    if (!((DIS_MASK >> 8) & 1) && RUN(0)) {
        LAS float* scr = (LAS float*)(lds + wave * 16384);
        constexpr int NITEMS = 2 * (1024 + 512 + 1408 + 1408 + 1408 + 512 + 128);
        for (int it = gw; it < NITEMS; it += NGW) {
            int r = it;
#define TR(Wsrc, K_, N_, WTdst, ROWMAP) { const int nblk = (N_) / 32, cnt = ((K_) / 64) * nblk; if (r < cnt) { const int kb = r / nblk, n0 = (r % nblk) * 32; \
                transpose_item((Wsrc), (K_), (N_), (WTdst), kb, n0, (ROWMAP), scr, lane); continue; } r -= cnt; }
#define TR_LAYER(l) \
            TR(args.in[(l) == 0 ? 2 : 6], D, DIN, (bf16*)(ws + WS_WIN) + (size_t)(l) * DIN * D, n0) \
            TR(args.in[(l) == 0 ? 3 : 7], D, D, (bf16*)(ws + WS_WOUT) + (size_t)(l) * D * D, n0) \
            TR(args.in[17] + (size_t)(l) * D * DFF, D, DFF, (bf16*)(ws + WS_WGU) + (size_t)(l) * 2 * DFF * D, (n0 / 128) * 256 + (n0 % 128)) \
            TR(args.in[18] + (size_t)(l) * D * DFF, D, DFF, (bf16*)(ws + WS_WGU) + (size_t)(l) * 2 * DFF * D, (n0 / 128) * 256 + 128 + (n0 % 128)) \
            TR(args.in[19] + (size_t)(l) * DFF * D, DFF, D, (bf16*)(ws + WS_WD) + (size_t)(l) * D * DFF, n0) \
            TR(args.in[23] + (size_t)(l) * D * D, D, D, (bf16*)(ws + WS_WPG) + (size_t)(l) * D * D, n0) \
            TR(args.in[22] + (size_t)(l) * PLE * D, PLE, D, (bf16*)(ws + WS_WPP) + (size_t)(l) * D * PLE, n0)
            TR_LAYER(0)
            TR_LAYER(1)
#undef TR_LAYER
#undef TR
        }
        const size_t gtid = (size_t)bid * NT + tid, gthreads = (size_t)G * NT;
        cvt_f32_bf16(args.in[0], XB, (size_t)M * D / 8, gtid, gthreads);
        cvt_f32_bf16(args.in[1], PB, (size_t)2 * M * PLE / 8, gtid, gthreads);
    }
    SEAM(0);

    for (int l = 0; l < 2; ++l) {
        const int pb = 1 + 8 * l;
        const bf16* Win_t = (const bf16*)(ws + WS_WIN) + (size_t)l * DIN * D;
        const bf16* Wout_t = (const bf16*)(ws + WS_WOUT) + (size_t)l * D * D;
        const bf16* Wgu_t = (const bf16*)(ws + WS_WGU) + (size_t)l * 2 * DFF * D;
        const bf16* Wd_t = (const bf16*)(ws + WS_WD) + (size_t)l * D * DFF;
        const bf16* Wpg_t = (const bf16*)(ws + WS_WPG) + (size_t)l * D * D;
        if (RUNJ(0)) {
            { pg8::EpiBf16<0> E{Hb, DIN, nullptr, 0, 0, 1.f}; run_gemm(lds, l == 0 ? XB : MIX, Win_t, DIN, D, E, G, bid); }
            if (l == 0) {
                for (int q = 0; q < 2; ++q) { pg8::EpiBf16<0> E{PP + (size_t)q * M * D, D, nullptr, 0, 0, 1.f};
                    run_gemm(lds, PB + (size_t)q * M * PLE, (const bf16*)(ws + WS_WPP) + (size_t)q * D * PLE, D, PLE, E, G, bid); }
            }
        }
        SEAM(pb + 0);
        if (RUNJ(1)) {
            int zq = 0; asm volatile("s_mov_b32 %0, 0" : "=s"(zq));
            const bf16* Hq = Hb + zq; bf16* Mq = MIX + zq; const int tidq = tid + zq, laneq = lane + zq;
            if (l == 0) {
                attn_simple(Hq, Mq, gw, NGW, laneq);
                pool_simple(Hq, Mq, args.in[4], args.in[5], (LAS float*)lds, bid, G, tidq);
            } else {
                conv_simple(Hq, Mq, args.in[8], args.in[9], args.in[10], (LAS float*)lds, bid, G, tidq, wave, laneq);
                sg_simple(Hq, Mq, args.in[11], args.in[12], args.in[13], args.in[14], (LAS float*)lds, (LAS float*)(lds + 65536), bid, G, tidq, wave, laneq);
            }
        }
        SEAM(pb + 1);
        if (RUNJ(2)) { EpiResid E{l == 0 ? args.in[0] : (const float*)XF, XF, D, ALPHA}; run_gemm(lds, MIX, Wout_t, D, D, E, G, bid); }
        SEAM(pb + 2);
        if (RUNJ(3)) ln_phase(XF, XB, args.in[15] + l * D, args.in[16] + l * D, gw, NGW, lane);
        SEAM(pb + 3);
        if (RUNJ(4)) { EpiSwiglu E{HFF, DFF}; run_gemm(lds, XB, Wgu_t, 2 * DFF, D, E, G, bid); }
        SEAM(pb + 4);
        if (RUNJ(5)) { EpiResid E{XF, XF, D, ALPHA}; run_gemm(lds, HFF, Wd_t, D, DFF, E, G, bid); }
        SEAM(pb + 5);
        if (RUNJ(6)) ln_phase(XF, XB, args.in[20] + l * D, args.in[21] + l * D, gw, NGW, lane);
        SEAM(pb + 6);
        if (RUNJ(7)) { EpiPle E{args.in[24] + l * D, PP + (size_t)l * M * D, XF, l == 0 ? MIX : (bf16*)nullptr}; run_gemm(lds, XB, Wpg_t, D, D, E, G, bid); }
        SEAM(pb + 7);
    }
#undef RUN
#undef SEAM
}

extern "C" void kernel_launch(void* const* d_in, const int* in_sizes, int n_in, void* d_out, int out_size, void* d_ws, size_t ws_size, hipStream_t stream) {
    static int grid = 0;
    if (grid == 0) {
        if (n_in != 25 || out_size != M * D || ws_size < WS_END) { fprintf(stderr, "kernel_launch: unexpected shapes (n_in %d, out %d, ws %zu)\n", n_in, out_size, ws_size); grid = -1; return; }
        int dev = 0, cus = 0, per_cu = 0;
        hipGetDevice(&dev); hipDeviceGetAttribute(&cus, hipDeviceAttributeMultiprocessorCount, dev);
        if (hipFuncSetAttribute((const void*)mega_fwd, hipFuncAttributeMaxDynamicSharedMemorySize, LDS_BYTES) != hipSuccess) { fprintf(stderr, "kernel_launch: hipFuncSetAttribute failed\n"); grid = -1; return; }
        if (hipOccupancyMaxActiveBlocksPerMultiprocessor(&per_cu, (const void*)mega_fwd, NT, LDS_BYTES) != hipSuccess || per_cu < 1) { fprintf(stderr, "kernel_launch: occupancy query gives %d\n", per_cu); per_cu = 1; }
        (void)hipGetLastError();
        grid = cus * (per_cu > 1 ? 1 : per_cu);
        fprintf(stderr, "kernel_launch: grid %d (cus %d, per_cu %d)\n", grid, cus, per_cu);
    }
    if (grid < 0) return;
    Args a{};
    for (int i = 0; i < 25; ++i) a.in[i] = (const float*)d_in[i];
    a.out = (float*)d_out; a.ws = (unsigned char*)d_ws;
#if MK_PER_PHASE
    for (int k = 0; k < N_PHASES; ++k) { a.ph_lo = k; a.ph_hi = k + 1; hipLaunchKernelGGL(mega_fwd, dim3(grid), dim3(NT), LDS_BYTES, stream, a); }
#else
    a.ph_lo = 0; a.ph_hi = N_PHASES;
    void* kargs[] = {&a};
    hipError_t e = hipLaunchCooperativeKernel((const void*)mega_fwd, dim3(grid), dim3(NT), kargs, LDS_BYTES, stream);
    if (e != hipSuccess) fprintf(stderr, "kernel_launch: cooperative launch failed: %s (grid %d)\n", hipGetErrorString(e), grid);
#endif
}
```

```cpp
#include <hip/hip_runtime.h>
#include <hip/hip_cooperative_groups.h>
#include <cstdio>
#include <cstdint>
namespace cg = cooperative_groups;
namespace pg8 {
#define PG8_LAS __attribute__((address_space(3)))
typedef unsigned short bf16_t;
typedef short bf16x8 __attribute__((ext_vector_type(8)));
typedef float f32x4 __attribute__((ext_vector_type(4)));
typedef unsigned u32x4 __attribute__((ext_vector_type(4)));
constexpr int BM = 256, BK = 64, HALF = 128, HTB = HALF * BK * 2  , STAGE_BYTES = 8 * HTB, NXCD = 8, WGM = 8;

__host__ __device__ __forceinline__ int lds_byte(int r, int c) { const int st = (r >> 4) * 2 + (c >> 5), rr = r & 15, cc = c & 31, ob = rr * 64 + cc * 2; return st * 1024 + (ob ^ (((ob >> 9) & 1) << 5)); }
__host__ __device__ __forceinline__ void stage_rc(int b, int& R, int& C) { const int st = b / 1024, sb = b % 1024, swz = sb ^ (((sb >> 9) & 1) << 5); R = (st >> 1) * 16 + swz / 64; C = (st & 1) * 32 + (swz % 64) / 2; }
__host__ __device__ __forceinline__ int perm32(int rho) { const int n = rho >> 4, i = rho & 15; return 8 * (i >> 2) + 4 * n + (i & 3); }

struct Unit { int pm, pn; };
struct Gemm { const bf16_t* A; const bf16_t* Bt; int M, N, K; };

struct StaticOrder {
    int nM, nN, nwg, G, c;
    __host__ __device__ void init(int M, int N, int G_, int c_) { nM = M / BM; nN = N / BM; nwg = nM * nN; G = G_; c = c_; }
    __host__ __device__ bool next(int i, Unit& u) const {
        const long L = (long)i * G + c; if (L >= nwg) return false;
        int wgid = (int)L; { const int q = nwg / NXCD, r = nwg % NXCD, xcd = wgid % NXCD, off = wgid / NXCD; wgid = (xcd < r ? xcd * (q + 1) : r * (q + 1) + (xcd - r) * q) + off; }
        const int nig = WGM * nN, gid = wgid / nig, fm = gid * WGM, gsz = (nM - fm) < WGM ? (nM - fm) : WGM;
        u.pm = fm + ((wgid % nig) % gsz); u.pn = (wgid % nig) / gsz; return true;
    }
    __device__ __forceinline__ void a_ready(const Unit&) const {}
    __device__ __forceinline__ void done(const Unit&) const {}
};

__device__ __forceinline__ unsigned cvt_pk_bf16(float lo, float hi) { unsigned r; asm volatile("v_cvt_pk_bf16_f32 %0, %1, %2" : "=v"(r) : "v"(lo), "v"(hi)); return r; }
typedef float f32x2 __attribute__((ext_vector_type(2)));
__device__ __forceinline__ f32x2 gelu_pk(f32x2 v) {
    const f32x2 av = __builtin_elementwise_abs(v), d = av * 0.2316418882f + 1.0f;
    f32x2 t; t.x = __builtin_amdgcn_rcpf(d.x); t.y = __builtin_amdgcn_rcpf(d.y);
    f32x2 q = t * 0.5307027145f + (-0.7265760135f); q = q * t + 0.7107068705f; q = q * t + (-0.142248368f); q = q * t + 0.127414796f; q = q * t;
    const f32x2 s = (v * v) * (-0.72134752044f);
    f32x2 e; e.x = __builtin_amdgcn_exp2f(s.x); e.y = __builtin_amdgcn_exp2f(s.y);
    const f32x2 m = v * (q * e), r = v - m;
    f32x2 o; o.x = v.x < 0.f ? m.x : r.x; o.y = v.y < 0.f ? m.y : r.y; return o;
}

template <int ACT  > struct EpiBf16 {
    static constexpr bool PERM = true, AFTER_DRAIN = false; static_assert(ACT == 0 || ACT == 1, "EpiBf16: ACT is 0 (none) or 1 (gelu_pk)");
    bf16_t* O; int ldc; const float* bias; int split_cols; size_t split_stride; float scale0;
    __device__ __forceinline__ void operator()(const f32x4 (&acc)[2][2][4][2], const Unit& u, int wr, int wc, int fr, int fq) const {
        const int row0 = u.pm * BM + wr * 64 + fr; int colt = u.pn * BM; bf16_t* base = O;
        float sc = 1.f; if (split_cols) { const int t = colt / split_cols; base += (size_t)t * split_stride; colt -= t * split_cols; if (t == 0) sc = scale0; }
        const int col0 = colt + wc * 32 + 8 * fq, bcol0 = u.pn * BM + wc * 32 + 8 * fq;
        f32x4 bv[2][2];
#pragma unroll
        for (int bj = 0; bj < 2; ++bj)
#pragma unroll
            for (int n = 0; n < 2; ++n) bv[bj][n] = bias ? *(const f32x4*)(bias + bcol0 + bj * HALF + 4 * n) : (f32x4){0.f, 0.f, 0.f, 0.f};
#pragma unroll
        for (int ai = 0; ai < 2; ++ai)
#pragma unroll
            for (int m = 0; m < 4; ++m) { bf16_t* rowp = base + (size_t)(row0 + ai * HALF + m * 16) * ldc + col0;
#pragma unroll
                for (int bj = 0; bj < 2; ++bj) { f32x4 v0 = acc[ai][bj][m][0] + bv[bj][0], v1 = acc[ai][bj][m][1] + bv[bj][1];
                    if (ACT == 1) { f32x2 a = gelu_pk((f32x2){v0[0], v0[1]}), b = gelu_pk((f32x2){v0[2], v0[3]}), c = gelu_pk((f32x2){v1[0], v1[1]}), d = gelu_pk((f32x2){v1[2], v1[3]});
                        v0 = (f32x4){a.x, a.y, b.x, b.y}; v1 = (f32x4){c.x, c.y, d.x, d.y}; }
                    v0 = v0 * sc; v1 = v1 * sc; u32x4 w; w.x = cvt_pk_bf16(v0[0], v0[1]); w.y = cvt_pk_bf16(v0[2], v0[3]); w.z = cvt_pk_bf16(v1[0], v1[1]); w.w = cvt_pk_bf16(v1[2], v1[3]);
                    *(u32x4*)(rowp + bj * HALF) = w; } }
    }
};

struct PanelStats {
    unsigned* xbuf;
    unsigned* cnt;
    unsigned* tmo;
    int ntn; float eps;
    unsigned code;
    __device__ __forceinline__ bool run(const f32x4 (&v)[2][2][4][2], const Unit& u, int wr, int wc, int fr, int fq, PG8_LAS unsigned char* lds, int wid, int lane) const {
        typedef float f32x2v __attribute__((ext_vector_type(2)));
        PG8_LAS f32x2v* P = (PG8_LAS f32x2v*)lds;
        PG8_LAS f32x2v* S = (PG8_LAS f32x2v*)(lds + 8192);
        PG8_LAS unsigned* flag = (PG8_LAS unsigned*)(lds + 8192 + 2048);
#pragma unroll
        for (int ai = 0; ai < 2; ++ai)
#pragma unroll
            for (int m = 0; m < 4; ++m) {
                float s = 0.f;
#pragma unroll
                for (int bj = 0; bj < 2; ++bj)
#pragma unroll
                    for (int n = 0; n < 2; ++n) { const f32x4 x = v[ai][bj][m][n]; s += (x[0] + x[1]) + (x[2] + x[3]); }
                s += __shfl_xor(s, 16); s += __shfl_xor(s, 32);
                const float mw = s * (1.0f / 64.0f); float q = 0.f;
#pragma unroll
                for (int bj = 0; bj < 2; ++bj)
#pragma unroll
                    for (int n = 0; n < 2; ++n) { const f32x4 d = v[ai][bj][m][n] - mw; q += (d[0] * d[0] + d[1] * d[1]) + (d[2] * d[2] + d[3] * d[3]); }
                q += __shfl_xor(q, 16); q += __shfl_xor(q, 32);
                if (fq == 0) P[(ai * HALF + wr * 64 + m * 16 + fr) * 4 + wc] = (f32x2v){mw, q};
            }
        asm volatile("s_waitcnt lgkmcnt(0)" ::: "memory"); __builtin_amdgcn_s_barrier(); asm volatile("" ::: "memory");
#if defined(BROKEN_EXCHANGE_NO_WAIT)
#warning BROKEN CONTROL BUILD: the row-statistics exchange does not wait; results are wrong by design
        if (blockIdx.x >= 64) { const long long t0_ = clock64(); while (clock64() - t0_ < 60000) __builtin_amdgcn_s_sleep(8); }
#endif
        const int row = wid * 32 + (lane & 31);
        if (lane < 32) {
            const f32x2v a = P[row * 4 + 0], b = P[row * 4 + 1], c = P[row * 4 + 2], d = P[row * 4 + 3];
            const float mt = (a.x + b.x + c.x + d.x) * 0.25f;
            const float da = a.x - mt, db = b.x - mt, dc = c.x - mt, dd = d.x - mt;
            const float m2 = (a.y + b.y) + (c.y + d.y) + 64.0f * ((da * da + db * db) + (dc * dc + dd * dd));
            unsigned long long* slot = (unsigned long long*)xbuf + ((size_t)(u.pm * BM + row) * 4 + u.pn);
            __hip_atomic_store(slot, ((unsigned long long)__float_as_uint(m2) << 32) | __float_as_uint(mt), __ATOMIC_RELAXED, __HIP_MEMORY_SCOPE_AGENT);
        }
        asm volatile("s_waitcnt vmcnt(0)" ::: "memory");
        if (lane == 0) __hip_atomic_fetch_add(cnt + 64 * u.pm, 1u, __ATOMIC_RELAXED, __HIP_MEMORY_SCOPE_AGENT);
        if (wid == 0) {
            bool dead = false; const unsigned long long t0 = __builtin_amdgcn_s_memrealtime(); const unsigned want = 8u * (unsigned)ntn;
            for (;;) {
#if defined(BROKEN_EXCHANGE_NO_WAIT)
                break;
#endif
                if ((unsigned)__builtin_amdgcn_readfirstlane(__hip_atomic_load(cnt + 64 * u.pm, __ATOMIC_RELAXED, __HIP_MEMORY_SCOPE_AGENT)) >= want) break;
                if (__builtin_amdgcn_s_memrealtime() - t0 > 2000000ull) {
                    if (lane == 0) { unsigned expect = 0u; __hip_atomic_compare_exchange_strong(tmo + 1, &expect, code | (unsigned)(u.pm & 0xff), __ATOMIC_RELAXED, __ATOMIC_RELAXED, __HIP_MEMORY_SCOPE_AGENT);
                                     __hip_atomic_store(tmo, 1u, __ATOMIC_RELAXED, __HIP_MEMORY_SCOPE_AGENT); }
                    dead = true; break; }
                __builtin_amdgcn_s_sleep(2);
            }
            __builtin_amdgcn_fence(__ATOMIC_ACQUIRE, "agent");
            if (lane == 0) flag[0] = dead ? 1u : 0u;
        }
        asm volatile("s_waitcnt vmcnt(0) lgkmcnt(0)" ::: "memory"); __builtin_amdgcn_s_barrier(); asm volatile("" ::: "memory");
        const bool bad = flag[0] != 0u;
        if (lane < 32) {
            const unsigned long long* slot = (const unsigned long long*)xbuf + (size_t)(u.pm * BM + row) * 4; float mt[4], m2[4]; float ms = 0.f;
#pragma unroll
            for (int t = 0; t < 4; ++t) { if (t < ntn) { const unsigned long long w = __hip_atomic_load(slot + t, __ATOMIC_RELAXED, __HIP_MEMORY_SCOPE_AGENT); mt[t] = __uint_as_float((unsigned)w); m2[t] = __uint_as_float((unsigned)(w >> 32)); } else { mt[t] = 0.f; m2[t] = 0.f; } ms += mt[t]; }
            const float mean = ms / (float)ntn; float q = 0.f;
#pragma unroll
            for (int t = 0; t < 4; ++t) if (t < ntn) { const float dm = mt[t] - mean; q += m2[t] + 256.0f * dm * dm; }
            S[row] = (f32x2v){mean, 1.0f / sqrtf(q / (256.0f * (float)ntn) + eps)};
        }
        asm volatile("s_waitcnt lgkmcnt(0)" ::: "memory"); __builtin_amdgcn_s_barrier(); asm volatile("" ::: "memory");
        return bad;
    }
};
struct EpiLnRes {
    static constexpr bool PERM = false, AFTER_DRAIN = true;
    const float* base; float* out; int ldc; const float* bias; PanelStats st; unsigned poison;
    __device__ __forceinline__ void fused(f32x4 (&acc)[2][2][4][2], const Unit& u, int wr, int wc, int fr, int fq, PG8_LAS unsigned char* lds, int wid, int lane) const {
        typedef float f32x2v __attribute__((ext_vector_type(2)));
        const PG8_LAS f32x2v* S = (const PG8_LAS f32x2v*)(lds + 8192);
        const int col0 = u.pn * BM + wc * 32 + 4 * fq;
#pragma unroll
        for (int bj = 0; bj < 2; ++bj)
#pragma unroll
            for (int n = 0; n < 2; ++n) { const f32x4 bv = bias ? *(const f32x4*)(bias + col0 + bj * HALF + n * 16) : (f32x4){0.f, 0.f, 0.f, 0.f};
#pragma unroll
                for (int ai = 0; ai < 2; ++ai)
#pragma unroll
                    for (int m = 0; m < 4; ++m) acc[ai][bj][m][n] += bv; }
        f32x4 pre[4][2][2];
#pragma unroll
        for (int m = 0; m < 4; ++m) { const size_t off = (size_t)(u.pm * BM + wr * 64 + m * 16 + fr) * ldc + col0;
#pragma unroll
            for (int bj = 0; bj < 2; ++bj)
#pragma unroll
                for (int n = 0; n < 2; ++n) pre[m][bj][n] = *(const f32x4*)(base + off + bj * HALF + n * 16); }
        const bool bad = st.run(acc, u, wr, wc, fr, fq, lds, wid, lane) || poison != 0u;
        const float qnan = __builtin_nanf("");
#pragma unroll
        for (int ai = 0; ai < 2; ++ai)
#pragma unroll
            for (int m = 0; m < 4; ++m) { const int r = ai * HALF + wr * 64 + m * 16 + fr; const f32x2v sr = S[r]; const size_t off = (size_t)(u.pm * BM + r) * ldc + col0;
#pragma unroll
                for (int bj = 0; bj < 2; ++bj)
#pragma unroll
                    for (int n = 0; n < 2; ++n) { const f32x4 bs = ai == 0 ? pre[m][bj][n] : *(const f32x4*)(base + off + bj * HALF + n * 16); f32x4 o = bs + (acc[ai][bj][m][n] - sr.x) * sr.y;
                        if (bad) o = (f32x4){qnan, qnan, qnan, qnan}; *(f32x4*)(out + off + bj * HALF + n * 16) = o; }
                if (m & 1) asm volatile("" ::: "memory"); }
    }
};
struct EpiLnResLn {
    static constexpr bool PERM = false, AFTER_DRAIN = true;
    const float* base; float* out; bf16_t* xn; int ldc; const float* bias; PanelStats st1, st2; unsigned poison;
    __device__ __forceinline__ void fused(f32x4 (&acc)[2][2][4][2], const Unit& u, int wr, int wc, int fr, int fq, PG8_LAS unsigned char* lds, int wid, int lane) const {
        typedef float f32x2v __attribute__((ext_vector_type(2))); typedef unsigned u32x2v __attribute__((ext_vector_type(2)));
        const PG8_LAS f32x2v* S = (const PG8_LAS f32x2v*)(lds + 8192);
        const int col0 = u.pn * BM + wc * 32 + 4 * fq;
#pragma unroll
        for (int bj = 0; bj < 2; ++bj)
#pragma unroll
            for (int n = 0; n < 2; ++n) { const f32x4 bv = bias ? *(const f32x4*)(bias + col0 + bj * HALF + n * 16) : (f32x4){0.f, 0.f, 0.f, 0.f};
#pragma unroll
                for (int ai = 0; ai < 2; ++ai)
#pragma unroll
                    for (int m = 0; m < 4; ++m) acc[ai][bj][m][n] += bv; }
        bool bad = st1.run(acc, u, wr, wc, fr, fq, lds, wid, lane) || poison != 0u;
        const float qnan = __builtin_nanf("");
#pragma unroll
        for (int ai = 0; ai < 2; ++ai)
#pragma unroll
            for (int m = 0; m < 4; ++m) { const int r = ai * HALF + wr * 64 + m * 16 + fr; const f32x2v sr = S[r]; const size_t off = (size_t)(u.pm * BM + r) * ldc + col0;
#pragma unroll
                for (int bj = 0; bj < 2; ++bj)
#pragma unroll
                    for (int n = 0; n < 2; ++n) { const f32x4 bs = *(const f32x4*)(base + off + bj * HALF + n * 16); acc[ai][bj][m][n] = bs + (acc[ai][bj][m][n] - sr.x) * sr.y; }
                asm volatile("" : "+v"(acc[ai][0][m][0]), "+v"(acc[ai][0][m][1]), "+v"(acc[ai][1][m][0]), "+v"(acc[ai][1][m][1]));
                if (m & 1) asm volatile("" ::: "memory"); }
        const bool bad1 = bad;
        bad = st2.run(acc, u, wr, wc, fr, fq, lds, wid, lane) || bad;
#pragma unroll
        for (int ai = 0; ai < 2; ++ai)
#pragma unroll
            for (int m = 0; m < 4; ++m) { const int r = ai * HALF + wr * 64 + m * 16 + fr; const f32x2v sr = S[r]; const size_t off = (size_t)(u.pm * BM + r) * ldc + col0;
#pragma unroll
                for (int bj = 0; bj < 2; ++bj)
#pragma unroll
                    for (int n = 0; n < 2; ++n) { const f32x4 x1 = acc[ai][bj][m][n]; *(f32x4*)(out + off + bj * HALF + n * 16) = bad1 ? (f32x4){qnan, qnan, qnan, qnan} : x1;
                        const f32x4 o = (x1 - sr.x) * sr.y; u32x2v w; w.x = cvt_pk_bf16(o[0], o[1]); w.y = cvt_pk_bf16(o[2], o[3]);
                        if (bad) { w.x = 0x7fc07fc0u; w.y = 0x7fc07fc0u; } *(u32x2v*)(xn + off + bj * HALF + n * 16) = w; }
                asm volatile("" ::: "memory"); }
    }
};

template <class Epi, class Sched, bool ALIGN_EPI = false, bool SP2 = false>
__device__ __forceinline__ void gemm_phase(PG8_LAS unsigned char* lds, const Gemm g, const Sched& S, const Epi& E) {
    const int tid = threadIdx.x, wid = __builtin_amdgcn_readfirstlane(tid >> 6), lane = tid & 63, wr = wid >> 2, wc = wid & 3, fr = lane & 15, fq = lane >> 4;
    const int K = g.K, nt = K / BK;
    unsigned voffA[2], voffB[2];
#pragma unroll
    for (int i = 0; i < 2; ++i) { int R, C; stage_rc(tid * 16 + i * 8192, R, C); const int Rb = Epi::PERM ? ((R & ~31) + perm32(R & 31)) : R;
        voffA[i] = (unsigned)(R * K + C) * 2u; voffB[i] = (unsigned)(Rb * K + C) * 2u; }
    const size_t kstep = (size_t)(BK * 2);
    const size_t hstep = (size_t)HALF * K * 2;
    const size_t tstep = 2 * hstep;
    const unsigned ldsw = (unsigned)wid * 1024u;
    const int aoff = lds_byte(wr * 64 + fr, fq * 8), boff = lds_byte(wc * 32 + fr, fq * 8);
#define PG8_SA(b, h) (((b) * 2 + (h)) * HTB)
#define PG8_SB(b, h) ((4 + (b) * 2 + (h)) * HTB)
#define PG8_STAGE(bufoff, gbase, voff) do { _Pragma("unroll") for (int _i = 0; _i < 2; ++_i) \
        __builtin_amdgcn_global_load_lds((const unsigned*)((const char*)(gbase) + (voff)[_i]), (PG8_LAS unsigned*)(lds + (bufoff) + ldsw + _i * 8192), 16, 0, 0); } while (0)
#define PG8_LDA(dst, b, h) do { _Pragma("unroll") for (int m = 0; m < 4; ++m) _Pragma("unroll") for (int k = 0; k < 2; ++k) dst[m][k] = *(const PG8_LAS bf16x8*)(lds + PG8_SA(b, h) + aoff + m * 2048 + k * 1024); } while (0)
#define PG8_LDB(dst, b, h) do { _Pragma("unroll") for (int n = 0; n < 2; ++n) _Pragma("unroll") for (int k = 0; k < 2; ++k) dst[n][k] = *(const PG8_LAS bf16x8*)(lds + PG8_SB(b, h) + boff + n * 2048 + k * 1024); } while (0)
#define PG8_MMA(ai, bj, At, Bt) do { __builtin_amdgcn_s_setprio(1); _Pragma("unroll") for (int m = 0; m < 4; ++m) _Pragma("unroll") for (int n = 0; n < 2; ++n) _Pragma("unroll") for (int k = 0; k < 2; ++k) \
        acc[ai][bj][m][n] = __builtin_amdgcn_mfma_f32_16x16x32_bf16(Bt[n][k], At[m][k], acc[ai][bj][m][n], 0, 0, 0); __builtin_amdgcn_s_setprio(0); } while (0)
#define PG8_WAIT_V(n) asm volatile("s_waitcnt vmcnt(" #n ")" ::: "memory")
#define PG8_WAIT_L(n) asm volatile("s_waitcnt lgkmcnt(" #n ")" ::: "memory")
#define PG8_BAR __builtin_amdgcn_s_barrier()
#define PG8_SCHED __builtin_amdgcn_sched_barrier(0)
    Unit cur, nxt; int ui = 0;
    if (!S.next(0, cur)) return;
    f32x4 acc[2][2][4][2];
#pragma unroll
    for (int a = 0; a < 2; ++a)
#pragma unroll
        for (int b = 0; b < 2; ++b)
#pragma unroll
            for (int m = 0; m < 4; ++m)
#pragma unroll
                for (int n = 0; n < 2; ++n) acc[a][b][m][n] = (f32x4){0.f, 0.f, 0.f, 0.f};
    bf16x8 At[4][2], B0[2][2], B1[2][2];
    const char* cA = (const char*)g.A + (size_t)cur.pm * tstep; const char* cB = (const char*)g.Bt + (size_t)cur.pn * tstep;
    S.a_ready(cur);
    if constexpr (SP2) {
        PG8_STAGE(PG8_SB(0, 0), cB, voffB); PG8_STAGE(PG8_SB(0, 1), cB + hstep, voffB); PG8_STAGE(PG8_SA(0, 0), cA, voffA); PG8_STAGE(PG8_SA(0, 1), cA + hstep, voffA);
        if (wr == 1) PG8_BAR;
        PG8_WAIT_V(2); PG8_BAR;
        PG8_STAGE(PG8_SB(1, 0), cB + kstep, voffB); PG8_STAGE(PG8_SA(1, 0), cA + kstep, voffA); PG8_STAGE(PG8_SB(1, 1), cB + hstep + kstep, voffB);
        PG8_WAIT_V(6); PG8_BAR;
    } else {
        PG8_STAGE(PG8_SB(0, 0), cB, voffB); PG8_STAGE(PG8_SA(0, 0), cA, voffA); PG8_STAGE(PG8_SB(0, 1), cB + hstep, voffB); PG8_STAGE(PG8_SA(0, 1), cA + hstep, voffA);
        if (wr == 1) PG8_BAR;
        PG8_WAIT_V(4); PG8_BAR;
        PG8_STAGE(PG8_SB(1, 0), cB + kstep, voffB); PG8_STAGE(PG8_SA(1, 0), cA + kstep, voffA); PG8_STAGE(PG8_SB(1, 1), cB + hstep + kstep, voffB);
        PG8_WAIT_V(6); PG8_BAR;
    }
    for (;;) {
        const bool has_next = S.next(ui + 1, nxt);
        const char* nA = has_next ? (const char*)g.A + (size_t)nxt.pm * tstep : cA; const char* nB = has_next ? (const char*)g.Bt + (size_t)nxt.pn * tstep : cB;
        for (int t = 0; t < nt; t += 2) {
            const bool last = (t == nt - 2);
            const char* a1 = cA + (size_t)(t + 1) * kstep;
            const char* a2 = last ? nA : cA + (size_t)(t + 2) * kstep; const char* b2 = last ? nB : cB + (size_t)(t + 2) * kstep;
            const char* a3 = a2 + kstep; const char* b3 = b2 + kstep;
            if (last && has_next) S.a_ready(nxt);
            if constexpr (SP2) {
            PG8_LDB(B0, 0, 0); PG8_LDB(B1, 0, 1); PG8_SCHED; PG8_LDA(At, 0, 0); PG8_STAGE(PG8_SA(1, 1), a1 + hstep, voffA);
            PG8_WAIT_V(8); PG8_WAIT_L(0); PG8_BAR; PG8_MMA(0, 0, At, B0); PG8_MMA(0, 1, At, B1); PG8_BAR; PG8_SCHED;
            PG8_LDA(At, 0, 1); PG8_STAGE(PG8_SB(0, 0), b2, voffB); PG8_STAGE(PG8_SB(0, 1), b2 + hstep, voffB); PG8_STAGE(PG8_SA(0, 0), a2, voffA);
            PG8_WAIT_V(8); PG8_WAIT_L(0); PG8_BAR; PG8_MMA(1, 0, At, B0); PG8_MMA(1, 1, At, B1); PG8_BAR; PG8_SCHED;
            PG8_LDB(B0, 1, 0); PG8_LDB(B1, 1, 1); PG8_SCHED; PG8_LDA(At, 1, 0); PG8_STAGE(PG8_SA(0, 1), a2 + hstep, voffA);
            PG8_WAIT_V(8); PG8_WAIT_L(0); PG8_BAR; PG8_MMA(0, 0, At, B0); PG8_MMA(0, 1, At, B1); PG8_BAR; PG8_SCHED;
            PG8_LDA(At, 1, 1); PG8_STAGE(PG8_SB(1, 0), b3, voffB); PG8_STAGE(PG8_SB(1, 1), b3 + hstep, voffB); PG8_STAGE(PG8_SA(1, 0), a3, voffA);
            PG8_WAIT_V(8); PG8_WAIT_L(0); PG8_BAR; PG8_MMA(1, 0, At, B0); PG8_MMA(1, 1, At, B1); PG8_BAR; PG8_SCHED;
            } else {
            PG8_LDB(B0, 0, 0); PG8_SCHED; PG8_LDA(At, 0, 0); PG8_STAGE(PG8_SA(1, 1), a1 + hstep, voffA);
            PG8_WAIT_L(8); PG8_BAR; PG8_WAIT_L(0); PG8_MMA(0, 0, At, B0); PG8_BAR; PG8_SCHED;
            PG8_LDB(B1, 0, 1); PG8_STAGE(PG8_SB(0, 0), b2, voffB);
            PG8_BAR; PG8_WAIT_L(0); PG8_MMA(0, 1, At, B1); PG8_BAR;
            PG8_LDA(At, 0, 1); PG8_STAGE(PG8_SA(0, 0), a2, voffA);
            PG8_BAR; PG8_WAIT_L(0); PG8_MMA(1, 0, At, B0); PG8_BAR; PG8_SCHED;
            PG8_STAGE(PG8_SB(0, 1), b2 + hstep, voffB);
            PG8_WAIT_V(6); PG8_BAR; PG8_MMA(1, 1, At, B1); PG8_BAR;
            PG8_LDB(B0, 1, 0); PG8_SCHED; PG8_LDA(At, 1, 0); PG8_STAGE(PG8_SA(0, 1), a2 + hstep, voffA);
            PG8_WAIT_L(8); PG8_BAR; PG8_WAIT_L(0); PG8_MMA(0, 0, At, B0); PG8_BAR; PG8_SCHED;
            PG8_LDB(B1, 1, 1); PG8_STAGE(PG8_SB(1, 0), b3, voffB);
            PG8_BAR; PG8_WAIT_L(0); PG8_MMA(0, 1, At, B1); PG8_BAR;
            PG8_LDA(At, 1, 1); PG8_STAGE(PG8_SA(1, 0), a3, voffA);
            PG8_BAR; PG8_WAIT_L(0); PG8_MMA(1, 0, At, B0); PG8_BAR; PG8_SCHED;
            PG8_STAGE(PG8_SB(1, 1), b3 + hstep, voffB);
            PG8_WAIT_V(6); PG8_BAR; PG8_MMA(1, 1, At, B1); PG8_BAR;
            }
        }
        if constexpr (ALIGN_EPI) { if (wr == 0) PG8_BAR; }
        if constexpr (!Epi::AFTER_DRAIN) { E(acc, cur, wr, wc, fr, fq); S.done(cur); }
        if (!has_next) break;
#pragma unroll
        for (int a = 0; a < 2; ++a)
#pragma unroll
            for (int b = 0; b < 2; ++b)
#pragma unroll
                for (int m = 0; m < 4; ++m)
#pragma unroll
                    for (int n = 0; n < 2; ++n) acc[a][b][m][n] = (f32x4){0.f, 0.f, 0.f, 0.f};
        cur = nxt; cA = nA; cB = nB; ++ui;
        if constexpr (ALIGN_EPI) { if (wr == 1) PG8_BAR; }
    }
    PG8_WAIT_V(0);
    if constexpr (!ALIGN_EPI) { if (wr == 0) PG8_BAR; }
    PG8_BAR;
    if constexpr (Epi::AFTER_DRAIN) { E.fused(acc, cur, wr, wc, fr, fq, lds, wid, lane); S.done(cur); }
#undef PG8_SA
#undef PG8_SB
#undef PG8_STAGE
#undef PG8_LDA
#undef PG8_LDB
#undef PG8_MMA
#undef PG8_WAIT_V
#undef PG8_WAIT_L
#undef PG8_BAR
#undef PG8_SCHED
}
}
#define LAS __attribute__((address_space(3)))
typedef unsigned short bf16;
typedef unsigned v4u __attribute__((ext_vector_type(4)));
typedef unsigned v2u __attribute__((ext_vector_type(2)));
typedef float f32x4 __attribute__((ext_vector_type(4)));
using pg8::bf16_t;

constexpr int NWAVES = 8, NT = 512;
constexpr int BATCH = 8, SEQ = 2048, M = BATCH * SEQ, D = 1024, DIN = 2048, DFF = 2816, PLE = 256;
constexpr float ALPHA = 1.4142135623730951f, LN_EPS = 1e-5f;
constexpr int N_PHASES = 17;
#ifndef MK_PER_PHASE
#define MK_PER_PHASE 0
#endif

constexpr size_t MiB = 1u << 20;
constexpr size_t WS_WIN = 1 * MiB, WS_WOUT = 9 * MiB, WS_WGU = 13 * MiB, WS_WD = 35 * MiB, WS_WPG = 46 * MiB, WS_WPP = 50 * MiB;
constexpr size_t WS_XB = 52 * MiB, WS_PP = 84 * MiB, WS_H = 148 * MiB, WS_MIX = 212 * MiB, WS_HFF = 148 * MiB, WS_END = 244 * MiB;
constexpr int LDS_BYTES = 135168;

#define LDS_WAIT() asm volatile("s_waitcnt lgkmcnt(0)" ::: "memory")
__device__ __forceinline__ unsigned f2bf(float f) { unsigned u = __builtin_bit_cast(unsigned, f); return (u + 0x7fffu + ((u >> 16) & 1u)) >> 16; }
__device__ __forceinline__ unsigned pk2(float lo, float hi) { return f2bf(lo) | (f2bf(hi) << 16); }
__device__ __forceinline__ float bf2f(bf16 v) { return __builtin_bit_cast(float, (unsigned)v << 16); }
__device__ __forceinline__ float bflo(unsigned w) { return __builtin_bit_cast(float, w << 16); }
__device__ __forceinline__ float bfhi(unsigned w) { return __builtin_bit_cast(float, w & 0xffff0000u); }
__device__ __forceinline__ float rl(float v, int l) { return __builtin_bit_cast(float, __builtin_amdgcn_readlane(__builtin_bit_cast(int, v), l)); }
__device__ __forceinline__ float fast_exp(float x) { return __builtin_amdgcn_exp2f(x * 1.4426950408889634f); }
__device__ __forceinline__ float sigmoidf_(float x) { return __builtin_amdgcn_rcpf(1.0f + fast_exp(-x)); }
__device__ __forceinline__ float siluf_(float x) { return x * sigmoidf_(x); }
__device__ __forceinline__ float softplusf_(float z) { return fmaxf(z, 0.f) + 0.6931471805599453f * __builtin_amdgcn_logf(1.0f + fast_exp(-fabsf(z))); }
__device__ __forceinline__ float gelu_tanh(float x) { const float y2 = 1.5957691216057308f * (x + 0.044715f * x * x * x); return x * sigmoidf_(y2); }
__device__ __forceinline__ float wave_sum(float v) {
#pragma unroll
    for (int o = 1; o < 64; o <<= 1) v += __shfl_xor(v, o);
    return v;
}

using pg8::Unit; using pg8::HALF; using pg8::BM;
struct EpiSwiglu {
    static constexpr bool PERM = true, AFTER_DRAIN = false;
    bf16_t* O; int ldc;
    __device__ __forceinline__ void operator()(const pg8::f32x4 (&acc)[2][2][4][2], const Unit& u, int wr, int wc, int fr, int fq) const {
        const int row0 = u.pm * BM + wr * 64 + fr, col0 = u.pn * HALF + wc * 32 + 8 * fq;
#pragma unroll
        for (int ai = 0; ai < 2; ++ai)
#pragma unroll
            for (int m = 0; m < 4; ++m) {
                bf16_t* rowp = O + (size_t)(row0 + ai * HALF + m * 16) * ldc + col0;
                const pg8::f32x4 g0 = acc[ai][0][m][0], g1 = acc[ai][0][m][1], u0 = acc[ai][1][m][0], u1 = acc[ai][1][m][1];
                pg8::u32x4 w;
                w.x = pg8::cvt_pk_bf16(siluf_(g0[0]) * u0[0], siluf_(g0[1]) * u0[1]); w.y = pg8::cvt_pk_bf16(siluf_(g0[2]) * u0[2], siluf_(g0[3]) * u0[3]);
                w.z = pg8::cvt_pk_bf16(siluf_(g1[0]) * u1[0], siluf_(g1[1]) * u1[1]); w.w = pg8::cvt_pk_bf16(siluf_(g1[2]) * u1[2], siluf_(g1[3]) * u1[3]);
                *(pg8::u32x4*)rowp = w;
            }
    }
};
struct EpiResid {
    static constexpr bool PERM = false, AFTER_DRAIN = false;
    const float* base; float* out; int ldc; float alpha;
    __device__ __forceinline__ void operator()(const pg8::f32x4 (&acc)[2][2][4][2], const Unit& u, int wr, int wc, int fr, int fq) const {
        const int col0 = u.pn * BM + wc * 32 + 4 * fq;
#pragma unroll
        for (int ai = 0; ai < 2; ++ai)
#pragma unroll
            for (int m = 0; m < 4; ++m) {
                const size_t off = (size_t)(u.pm * BM + ai * HALF + wr * 64 + m * 16 + fr) * ldc + col0;
#pragma unroll
                for (int bj = 0; bj < 2; ++bj)
#pragma unroll
                    for (int n = 0; n < 2; ++n) { const size_t o = off + bj * HALF + n * 16; const pg8::f32x4 bs = *(const pg8::f32x4*)(base + o); *(pg8::f32x4*)(out + o) = bs * alpha + acc[ai][bj][m][n]; }
                asm volatile("" ::: "memory");
            }
    }
};
struct EpiPle {
    static constexpr bool PERM = false, AFTER_DRAIN = false;
    const float* bias; const bf16_t* pp; float* xf; bf16_t* xb;
    __device__ __forceinline__ void operator()(const pg8::f32x4 (&acc)[2][2][4][2], const Unit& u, int wr, int wc, int fr, int fq) const {
        const int col0 = u.pn * BM + wc * 32 + 4 * fq;
        pg8::f32x4 bv[2][2];
#pragma unroll
        for (int bj = 0; bj < 2; ++bj)
#pragma unroll
            for (int n = 0; n < 2; ++n) bv[bj][n] = *(const pg8::f32x4*)(bias + col0 + bj * HALF + n * 16);
#pragma unroll
        for (int ai = 0; ai < 2; ++ai)
#pragma unroll
            for (int m = 0; m < 4; ++m) {
                const size_t off = (size_t)(u.pm * BM + ai * HALF + wr * 64 + m * 16 + fr) * D + col0;
#pragma unroll
                for (int bj = 0; bj < 2; ++bj)
#pragma unroll
                    for (int n = 0; n < 2; ++n) {
                        const size_t o = off + bj * HALF + n * 16;
                        const pg8::f32x4 x2 = *(const pg8::f32x4*)(xf + o); const v2u pw = *(const v2u*)(pp + o);
                        const pg8::f32x4 a = acc[ai][bj][m][n] + bv[bj][n];
                        pg8::f32x4 r;
                        r[0] = x2[0] + sigmoidf_(a[0]) * bflo(pw.x); r[1] = x2[1] + sigmoidf_(a[1]) * bfhi(pw.x);
                        r[2] = x2[2] + sigmoidf_(a[2]) * bflo(pw.y); r[3] = x2[3] + sigmoidf_(a[3]) * bfhi(pw.y);
                        *(pg8::f32x4*)(xf + o) = r;
                        if (xb) { v2u w; w.x = pg8::cvt_pk_bf16(r[0], r[1]); w.y = pg8::cvt_pk_bf16(r[2], r[3]); *(v2u*)(xb + o) = w; }
                    }
                asm volatile("" ::: "memory");
            }
    }
};


struct EpiInProj {
    static constexpr bool PERM = true, AFTER_DRAIN = false;
    bf16_t* O; bf16_t* VT;
    __device__ __forceinline__ void operator()(const pg8::f32x4 (&acc)[2][2][4][2], const Unit& u, int wr, int wc, int fr, int fq) const {
        const int row0 = u.pm * BM + wr * 64 + fr, col0 = u.pn * BM + wc * 32 + 8 * fq;
        if (VT != nullptr && (u.pn == 4 || u.pn == 5)) {
#pragma unroll
            for (int ai = 0; ai < 2; ++ai)
#pragma unroll
                for (int m = 0; m < 4; ++m) { const int r = row0 + ai * HALF + m * 16, b = r >> 11, t = r & (SEQ - 1);
#pragma unroll
                    for (int bj = 0; bj < 2; ++bj) { bf16_t* vp = VT + ((size_t)b * 512 + (col0 - 1024 + bj * HALF)) * SEQ + t;
#pragma unroll
                        for (int n = 0; n < 2; ++n)
#pragma unroll
                            for (int e = 0; e < 4; ++e) vp[(size_t)(4 * n + e) * SEQ] = (bf16_t)f2bf(acc[ai][bj][m][n][e]); } }
        } else {
#pragma unroll
            for (int ai = 0; ai < 2; ++ai)
#pragma unroll
                for (int m = 0; m < 4; ++m) { bf16_t* rowp = O + (size_t)(row0 + ai * HALF + m * 16) * DIN + col0;
#pragma unroll
                    for (int bj = 0; bj < 2; ++bj) { const pg8::f32x4 v0 = acc[ai][bj][m][0], v1 = acc[ai][bj][m][1]; pg8::u32x4 w;
                        w.x = pg8::cvt_pk_bf16(v0[0], v0[1]); w.y = pg8::cvt_pk_bf16(v0[2], v0[3]); w.z = pg8::cvt_pk_bf16(v1[0], v1[1]); w.w = pg8::cvt_pk_bf16(v1[2], v1[3]);
                        *(pg8::u32x4*)(rowp + bj * HALF) = w; } }
        }
    }
};

template <class Epi>
__device__ __forceinline__ void run_gemm(LAS unsigned char* lds, const bf16_t* A, const bf16_t* Bt, int N, int K, const Epi& E, int G, int bid) {
    int zq = 0; asm volatile("s_mov_b32 %0, 0" : "=s"(zq));
    K += zq; N += zq;
    pg8::Gemm g{A, Bt, M, N, K}; pg8::StaticOrder S; S.init(M, N, G, bid);
    pg8::gemm_phase<Epi, pg8::StaticOrder, true, true>(lds, g, S, E);
}

__device__ __forceinline__ void transpose_item(const float* W, int K, int N, bf16* WT, int kb, int n0, int dst_row0, LAS float* scr, int lane) {
    const int k0 = 64 * kb;
#pragma unroll 8
    for (int i = 0; i < 32; ++i) { const int kk = 2 * i + (lane >> 5); scr[kk * 33 + (lane & 31)] = W[(size_t)(k0 + kk) * N + n0 + (lane & 31)]; }
    LDS_WAIT();
    const int c = lane & 7;
#pragma unroll
    for (int j = 0; j < 4; ++j) { const int n = (lane >> 3) + 8 * j; const LAS float* s = scr + (8 * c) * 33 + n;
        v4u o; o.x = pk2(s[0 * 33], s[1 * 33]); o.y = pk2(s[2 * 33], s[3 * 33]); o.z = pk2(s[4 * 33], s[5 * 33]); o.w = pk2(s[6 * 33], s[7 * 33]);
        *(v4u*)(WT + (size_t)(dst_row0 + n) * K + k0 + 8 * c) = o; }
    LDS_WAIT();
}
__device__ __forceinline__ void cvt_f32_bf16(const float* src, bf16* dst, size_t n8, size_t gtid, size_t gthreads) {
    for (size_t i = gtid; i < n8; i += gthreads) {
        const f32x4 a = ((const f32x4*)src)[2 * i], b = ((const f32x4*)src)[2 * i + 1];
        v4u o; o.x = pk2(a[0], a[1]); o.y = pk2(a[2], a[3]); o.z = pk2(b[0], b[1]); o.w = pk2(b[2], b[3]);
        ((v4u*)dst)[i] = o;
    }
}
__device__ __forceinline__ void ln_phase(float* buf, bf16* xb, const float* g, const float* b, int gw, int NGW, int lane) {
    for (int m = gw; m < M; m += NGW) {
        f32x4* xr = (f32x4*)(buf + (size_t)m * D) + lane;
        f32x4 v[4]; float s = 0.f;
#pragma unroll
        for (int j = 0; j < 4; ++j) { v[j] = xr[64 * j]; s += (v[j][0] + v[j][1]) + (v[j][2] + v[j][3]); }
        const float mean = wave_sum(s) * (1.f / D); float s2 = 0.f;
#pragma unroll
        for (int j = 0; j < 4; ++j) { v[j] = v[j] - mean; s2 += (v[j][0] * v[j][0] + v[j][1] * v[j][1]) + (v[j][2] * v[j][2] + v[j][3] * v[j][3]); }
        const float rstd = 1.f / sqrtf(wave_sum(s2) * (1.f / D) + LN_EPS);
        v2u* o8 = (v2u*)(xb + (size_t)m * D) + lane;
#pragma unroll
        for (int j = 0; j < 4; ++j) {
            const f32x4 gg = ((const f32x4*)g)[lane + 64 * j], bb = ((const f32x4*)b)[lane + 64 * j];
            const f32x4 o = v[j] * rstd * gg + bb;
            xr[64 * j] = o; v2u w; w.x = pk2(o[0], o[1]); w.y = pk2(o[2], o[3]); o8[64 * j] = w;
        }
    }
}

__device__ __forceinline__ void attn_simple(const bf16* Hb, bf16* MIX, int gw, int NGW, int lane) {
    for (int item = gw; item < BATCH * 8 * SEQ; item += NGW) {
        const int t = item & (SEQ - 1), bh = item >> 11, b = bh >> 3, h = bh & 7;
        const bf16* base = Hb + (size_t)b * SEQ * DIN + h * 64;
        const float qv = bf2f(base[(size_t)t * DIN + lane]) * 0.125f;
        float o = 0.f, carry = 0.f;
        for (int hi = t; hi > 0; hi -= 64) {
            const int s = hi - 64 + lane; const bool valid = s >= 0; const int sc = valid ? s : 0;
            const bf16* krow = base + (size_t)sc * DIN + 512;
            float z = 0.f;
#pragma unroll
            for (int i = 0; i < 8; ++i) { const v4u kk = *(const v4u*)(krow + 8 * i);
                z += rl(qv, 8 * i + 0) * bflo(kk.x); z += rl(qv, 8 * i + 1) * bfhi(kk.x); z += rl(qv, 8 * i + 2) * bflo(kk.y); z += rl(qv, 8 * i + 3) * bfhi(kk.y);
                z += rl(qv, 8 * i + 4) * bflo(kk.z); z += rl(qv, 8 * i + 5) * bfhi(kk.z); z += rl(qv, 8 * i + 6) * bflo(kk.w); z += rl(qv, 8 * i + 7) * bfhi(kk.w); }
            const float L = valid ? -softplusf_(z) : 0.f;
            float R = L;
#pragma unroll
            for (int off = 1; off < 64; off <<= 1) { const float tmp = __shfl_down(R, off); if (lane + off < 64) R += tmp; }
            const float tot = rl(R, 0);
            const float w = valid ? fast_exp(z + R + carry) : 0.f;
            carry += tot;
#pragma unroll 16
            for (int j = 0; j < 64; ++j) { const float wj = __shfl(w, j); int sj = hi - 64 + j; sj = sj < 0 ? 0 : sj;
                o += wj * bf2f(base[(size_t)sj * DIN + 1024 + lane]); }
            if (carry < -110.f) break;
        }
        MIX[((size_t)b * SEQ + t) * D + h * 64 + lane] = (bf16)f2bf(o);
    }
}

typedef short bf16x8v __attribute__((ext_vector_type(8)));
typedef float f32x16 __attribute__((ext_vector_type(16)));
__device__ __forceinline__ void attn_mfma(const bf16* Hb, const bf16* VT, bf16* MIX, int gw, int NGW, int lane) {
    const int ln = lane & 31, hi = lane >> 5;
    bf16x8v tri[2];
#pragma unroll
    for (int ks2 = 0; ks2 < 2; ++ks2)
#pragma unroll
        for (int e = 0; e < 8; ++e) { const int j = 16 * ks2 + 8 * (e >> 2) + 4 * hi + (e & 3); tri[ks2][e] = (j >= ln) ? (short)0x3F80 : (short)0; }
    for (int item = gw; item < 64 * 64; item += NGW) {
        const int qb = item & 63, bh = item >> 6, b = bh >> 3, h = bh & 7;
        const int t0 = qb * 32, t = t0 + ln;
        const bf16* qp = Hb + ((size_t)(b * SEQ + t)) * DIN + h * 64 + 8 * hi;
        bf16x8v qf[4];
#pragma unroll
        for (int ks = 0; ks < 4; ++ks) qf[ks] = *(const bf16x8v*)(qp + 16 * ks);
        f32x16 o0, o1;
#pragma unroll
        for (int r = 0; r < 16; ++r) { o0[r] = 0.f; o1[r] = 0.f; }
        float cr = 0.f;
        const bf16* kbase = Hb + (size_t)b * SEQ * DIN + 512 + h * 64 + 8 * hi;
        const bf16* vbase = VT + ((size_t)(bh * 64 + ln)) * SEQ + 4 * hi;
        for (int sb = t0; sb >= 0; sb -= 32) {
            const bf16* kp = kbase + (size_t)(sb + ln) * DIN;
            bf16x8v kf[4];
#pragma unroll
            for (int ks = 0; ks < 4; ++ks) kf[ks] = *(const bf16x8v*)(kp + 16 * ks);
            v2u va[2][2], vb[2][2];
#pragma unroll
            for (int db = 0; db < 2; ++db)
#pragma unroll
                for (int ks2 = 0; ks2 < 2; ++ks2) { const bf16* vp = vbase + (size_t)db * 32 * SEQ + sb + 16 * ks2; va[db][ks2] = *(const v2u*)vp; vb[db][ks2] = *(const v2u*)(vp + 8); }
            f32x16 st;
#pragma unroll
            for (int r = 0; r < 16; ++r) st[r] = 0.f;
#pragma unroll
            for (int ks = 0; ks < 4; ++ks) st = __builtin_amdgcn_mfma_f32_32x32x16_bf16(kf[ks], qf[ks], st, 0, 0, 0);
            unsigned hb[16], lb[16]; float zz[16];
#pragma unroll
            for (int r = 0; r < 16; ++r) {
                const int key = sb + 8 * (r >> 2) + 4 * hi + (r & 3); const bool valid = key < t;
                zz[r] = st[r] * 0.125f;
                const float L = valid ? -softplusf_(zz[r]) : 0.f;
                hb[r] = f2bf(L); lb[r] = f2bf(L - __builtin_bit_cast(float, hb[r] << 16));
            }
            bf16x8v Bh[2], Bl[2];
#pragma unroll
            for (int ks2 = 0; ks2 < 2; ++ks2)
#pragma unroll
                for (int e = 0; e < 8; ++e) { Bh[ks2][e] = (short)hb[8 * ks2 + e]; Bl[ks2][e] = (short)lb[8 * ks2 + e]; }
            f32x16 R;
#pragma unroll
            for (int r = 0; r < 16; ++r) R[r] = cr;
            R = __builtin_amdgcn_mfma_f32_32x32x16_bf16(tri[0], Bh[0], R, 0, 0, 0);
            R = __builtin_amdgcn_mfma_f32_32x32x16_bf16(tri[1], Bh[1], R, 0, 0, 0);
            R = __builtin_amdgcn_mfma_f32_32x32x16_bf16(tri[0], Bl[0], R, 0, 0, 0);
            R = __builtin_amdgcn_mfma_f32_32x32x16_bf16(tri[1], Bl[1], R, 0, 0, 0);
            bf16x8v pk[2];
#pragma unroll
            for (int r = 0; r < 16; ++r) {
                const int key = sb + 8 * (r >> 2) + 4 * hi + (r & 3); const bool valid = key < t;
                const float w = valid ? fast_exp(zz[r] + R[r]) : 0.f;
                pk[r >> 3][r & 7] = (short)f2bf(w);
            }
            cr = __shfl(R[0], ln);
#pragma unroll
            for (int ks2 = 0; ks2 < 2; ++ks2) {
                bf16x8v v0, v1;
                { const v4u q = (v4u){va[0][ks2].x, va[0][ks2].y, vb[0][ks2].x, vb[0][ks2].y}; v0 = __builtin_bit_cast(bf16x8v, q); }
                { const v4u q = (v4u){va[1][ks2].x, va[1][ks2].y, vb[1][ks2].x, vb[1][ks2].y}; v1 = __builtin_bit_cast(bf16x8v, q); }
                o0 = __builtin_amdgcn_mfma_f32_32x32x16_bf16(v0, pk[ks2], o0, 0, 0, 0);
                o1 = __builtin_amdgcn_mfma_f32_32x32x16_bf16(v1, pk[ks2], o1, 0, 0, 0);
            }
            if (__all(cr < -110.f)) break;
        }
        bf16* op = MIX + ((size_t)(b * SEQ + t)) * D + h * 64 + 4 * hi;
#pragma unroll
        for (int i = 0; i < 4; ++i) {
            v2u w0; w0.x = pk2(o0[4 * i], o0[4 * i + 1]); w0.y = pk2(o0[4 * i + 2], o0[4 * i + 3]); *(v2u*)(op + 8 * i) = w0;
            v2u w1; w1.x = pk2(o1[4 * i], o1[4 * i + 1]); w1.y = pk2(o1[4 * i + 2], o1[4 * i + 3]); *(v2u*)(op + 32 + 8 * i) = w1;
        }
    }
}

__device__ __forceinline__ void pool_simple(const bf16* Hb, bf16* MIX, const float* pool_w, const float* pool_scale, LAS float* P, int bid, int G, int tid) {
    for (int unit = bid; unit < (M / 32) * 4; unit += G) {
        const int g = unit & 3, row0 = (unit >> 2) * 32, t0 = row0 & (SEQ - 1), w = 2 << g;
        for (int e = tid; e < 32 * 128; e += NT) {
            const int r = e >> 7, c = e & 127, t = t0 + r;
            const bf16* up = Hb + (size_t)(row0 + r) * DIN + 1536 + g * 128 + c;
            float sum = 0.f;
            for (int j = 0; j < w; ++j) if (t - j >= 0) sum += bf2f(*(up - (size_t)j * DIN));
            const int cnt = (t + 1) < w ? (t + 1) : w;
            P[r * 128 + c] = sum / (float)cnt - bf2f(*up);
        }
        __syncthreads();
        const int d = tid & 127, rq = tid >> 7;
        float acc[8];
#pragma unroll
        for (int i = 0; i < 8; ++i) acc[i] = 0.f;
        const float* wp = pool_w + (size_t)g * 128 * 128 + d;
        for (int c = 0; c < 128; ++c) { const float wv = wp[(size_t)c * 128];
#pragma unroll
            for (int i = 0; i < 8; ++i) acc[i] += P[(rq * 8 + i) * 128 + c] * wv; }
        const float sc = pool_scale[g * 128 + d];
#pragma unroll
        for (int i = 0; i < 8; ++i) MIX[(size_t)(row0 + rq * 8 + i) * D + 512 + g * 128 + d] = (bf16)f2bf(acc[i] * sc);
        __syncthreads();
    }
}
__device__ __forceinline__ void conv_simple(const bf16* Hb, bf16* MIX, const float* dw, const float* ln_g, const float* ln_b, LAS float* hh, int bid, int G, int tid, int wave, int lane) {
    for (int unit = bid; unit < M / 32; unit += G) {
        const int row0 = unit * 32, t0 = row0 & (SEQ - 1);
        for (int e = tid; e < 62 * 512; e += NT) {
            const int r = e >> 9, c = e & 511, t = t0 - 30 + r;
            float val = 0.f;
            if (t >= 0) { const bf16* p = Hb + (size_t)(row0 - 30 + r) * DIN + c; val = bf2f(p[0]) * sigmoidf_(bf2f(p[512])); }
            hh[r * 512 + c] = val;
        }
        __syncthreads();
        {
            const int c = tid;
            float wk[31];
#pragma unroll
            for (int k = 0; k < 31; ++k) wk[k] = dw[k * 512 + c];
            for (int i = 0; i < 32; ++i) {
                float y = 0.f;
#pragma unroll
                for (int k = 0; k < 31; ++k) y += wk[k] * hh[(i + k) * 512 + c];
                hh[i * 512 + c] = y;
            }
        }
        __syncthreads();
        for (int i = wave * 4; i < wave * 4 + 4; ++i) {
            float v[8]; float s = 0.f;
#pragma unroll
            for (int j = 0; j < 8; ++j) { v[j] = hh[i * 512 + lane + 64 * j]; s += v[j]; }
            const float mean = wave_sum(s) * (1.f / 512.f); float s2 = 0.f;
#pragma unroll
            for (int j = 0; j < 8; ++j) { v[j] -= mean; s2 += v[j] * v[j]; }
            const float rstd = 1.f / sqrtf(wave_sum(s2) * (1.f / 512.f) + LN_EPS);
#pragma unroll
            for (int j = 0; j < 8; ++j) { const int c = lane + 64 * j; const float y = v[j] * rstd * ln_g[c] + ln_b[c];
                MIX[(size_t)(row0 + i) * D + c] = (bf16)f2bf(siluf_(y)); }
        }
        __syncthreads();
    }
}
__device__ __forceinline__ void sg_simple(const bf16* Hb, bf16* MIX, const float* ln_g, const float* ln_b, const float* sg_w, const float* sg_b, LAS float* V, LAS float* ST,
                                          int bid, int G, int tid, int wave, int lane) {
    for (int unit = bid; unit < (M / 128) * 4; unit += G) {
        const int g = unit & 3, row0 = (unit >> 2) * 128;
        for (int r = wave * 16; r < wave * 16 + 16; ++r) {
            const bf16* vp = Hb + (size_t)(row0 + r) * DIN + 1536;
            float v[8]; float s = 0.f;
#pragma unroll
            for (int j = 0; j < 8; ++j) { v[j] = gelu_tanh(bf2f(vp[lane + 64 * j])); s += v[j]; }
            const float mean = wave_sum(s) * (1.f / 512.f); float s2 = 0.f;
#pragma unroll
            for (int j = 0; j < 8; ++j) { const float dlt = v[j] - mean; s2 += dlt * dlt; }
            const float rstd = 1.f / sqrtf(wave_sum(s2) * (1.f / 512.f) + LN_EPS);
            if (lane == 0) { ST[2 * r] = mean; ST[2 * r + 1] = rstd; }
        }
        __syncthreads();
        for (int e = tid; e < 128 * 128; e += NT) {
            const int s = e >> 7, d = e & 127, c = g * 128 + d;
            const float v = gelu_tanh(bf2f(Hb[(size_t)(row0 + s) * DIN + 1536 + c]));
            V[s * 128 + d] = (v - ST[2 * s]) * ST[2 * s + 1] * ln_g[c] + ln_b[c];
        }
        __syncthreads();
        {
            const int d = tid & 127, tq = tid >> 7;
            for (int i = 0; i < 32; ++i) {
                const int t = tq + 4 * i;
                const float* wrow = sg_w + ((size_t)g * 128 + t) * 128;
                float acc = 0.f;
                for (int s = 0; s <= t; ++s) acc += wrow[s] * V[s * 128 + d];
                const float sv = acc + sg_b[g * 128 + t];
                const float uu = gelu_tanh(bf2f(Hb[(size_t)(row0 + t) * DIN + 1024 + g * 128 + d]));
                MIX[(size_t)(row0 + t) * D + 512 + g * 128 + d] = (bf16)f2bf(uu * sv);
            }
        }
        __syncthreads();
    }
}

struct Args { const float* in[25]; float* out; unsigned char* ws; int ph_lo, ph_hi; };
typedef const __attribute__((address_space(4))) Args* KArgP;
#define PHASE_ARGS() KArgP ap = (KArgP)__builtin_amdgcn_kernarg_segment_ptr(); asm volatile("" : "+s"(ap)); int zq = 0; asm volatile("s_mov_b32 %0, 0" : "=s"(zq)); \
    unsigned char* const ws = ap->ws + zq; (void)ws
__global__ void __launch_bounds__(NT, 2) mega_fwd(Args args) {
    extern __shared__ __attribute__((aligned(16))) unsigned char lds_raw[];
    cg::grid_group grid = cg::this_grid();
    LAS unsigned char* lds = (LAS unsigned char*)lds_raw;
    const int tid = threadIdx.x, lane = tid & 63, wave = __builtin_amdgcn_readfirstlane(tid >> 6);
    const int G = gridDim.x, bid = blockIdx.x;
    const int gw = bid * NWAVES + wave, NGW = G * NWAVES;
    const int lo = args.ph_lo, hi = args.ph_hi;
#ifndef DIS_MASK
#define DIS_MASK 0
#endif
#define RUN(k) (lo <= (k) && (k) < hi)
#define RUNJ(j) (!((DIS_MASK >> (j)) & 1) && RUN(pb + (j)))
#define SEAM(k) do { if (lo <= (k) && (k) + 1 < hi) grid.sync(); } while (0)
#define WSB(off) ((bf16*)(ws + (off)))

    if (!((DIS_MASK >> 8) & 1) && RUN(0)) {
        PHASE_ARGS();
        LAS float* scr = (LAS float*)(lds + wave * 16384);
        constexpr int NITEMS = 2 * (1024 + 512 + 1408 + 1408 + 1408 + 512 + 128);
        for (int it = gw; it < NITEMS; it += NGW) {
            int r = it;
#define TR(Wsrc, K_, N_, WTdst, ROWMAP) { const int nblk = (N_) / 32, cnt = ((K_) / 64) * nblk; if (r < cnt) { const int kb = r / nblk, n0 = (r % nblk) * 32; \
                transpose_item((Wsrc), (K_), (N_), (WTdst), kb, n0, (ROWMAP), scr, lane); continue; } r -= cnt; }
#define TR_LAYER(l) \
            TR(ap->in[(l) == 0 ? 2 : 6], D, DIN, WSB(WS_WIN) + (size_t)(l) * DIN * D, n0) \
            TR(ap->in[(l) == 0 ? 3 : 7], D, D, WSB(WS_WOUT) + (size_t)(l) * D * D, n0) \
            TR(ap->in[17] + (size_t)(l) * D * DFF, D, DFF, WSB(WS_WGU) + (size_t)(l) * 2 * DFF * D, (n0 / 128) * 256 + (n0 % 128)) \
            TR(ap->in[18] + (size_t)(l) * D * DFF, D, DFF, WSB(WS_WGU) + (size_t)(l) * 2 * DFF * D, (n0 / 128) * 256 + 128 + (n0 % 128)) \
            TR(ap->in[19] + (size_t)(l) * DFF * D, DFF, D, WSB(WS_WD) + (size_t)(l) * D * DFF, n0) \
            TR(ap->in[23] + (size_t)(l) * D * D, D, D, WSB(WS_WPG) + (size_t)(l) * D * D, n0) \
            TR(ap->in[22] + (size_t)(l) * PLE * D, PLE, D, WSB(WS_WPP) + (size_t)(l) * D * PLE, n0)
            TR_LAYER(0)
            TR_LAYER(1)
#undef TR_LAYER
#undef TR
        }
        const size_t gtid = (size_t)bid * NT + tid, gthreads = (size_t)G * NT;
        cvt_f32_bf16(ap->in[0], WSB(WS_XB), (size_t)M * D / 8, gtid, gthreads);
        cvt_f32_bf16(ap->in[1], (bf16*)ap->out, (size_t)2 * M * PLE / 8, gtid, gthreads);
    }
    SEAM(0);

    for (int l = 0; l < 2; ++l) {
        const int pb = 1 + 8 * l;
        if (RUNJ(0)) {
            PHASE_ARGS();
            bf16* VT = (bf16*)ap->out + (size_t)2 * M * PLE;
            { EpiInProj E{WSB(WS_H), l == 0 ? VT : (bf16*)nullptr}; run_gemm(lds, l == 0 ? WSB(WS_XB) : WSB(WS_MIX), WSB(WS_WIN) + (size_t)l * DIN * D, DIN, D, E, G, bid); }
            if (l == 0) {
                for (int q = 0; q < 2; ++q) { pg8::EpiBf16<0> E{WSB(WS_PP) + (size_t)q * M * D, D, nullptr, 0, 0, 1.f};
                    run_gemm(lds, (bf16*)ap->out + (size_t)q * M * PLE, WSB(WS_WPP) + (size_t)q * D * PLE, D, PLE, E, G, bid); }
            }
        }
        SEAM(pb + 0);
        if (RUNJ(1)) {
            PHASE_ARGS();
            const bf16* Hq = WSB(WS_H); bf16* Mq = WSB(WS_MIX); const int tidq = tid + zq, laneq = lane + zq;
            if (l == 0) {
                attn_mfma(Hq, (bf16*)ap->out + (size_t)2 * M * PLE, Mq, gw, NGW, laneq);
                pool_simple(Hq, Mq, ap->in[4], ap->in[5], (LAS float*)lds, bid, G, tidq);
            } else {
                conv_simple(Hq, Mq, ap->in[8], ap->in[9], ap->in[10], (LAS float*)lds, bid, G, tidq, wave, laneq);
                sg_simple(Hq, Mq, ap->in[11], ap->in[12], ap->in[13], ap->in[14], (LAS float*)lds, (LAS float*)(lds + 65536), bid, G, tidq, wave, laneq);
            }
        }
        SEAM(pb + 1);
        if (RUNJ(2)) { PHASE_ARGS(); EpiResid E{l == 0 ? ap->in[0] : (const float*)ap->out, ap->out, D, ALPHA}; run_gemm(lds, WSB(WS_MIX), WSB(WS_WOUT) + (size_t)l * D * D, D, D, E, G, bid); }
        SEAM(pb + 2);
        if (RUNJ(3)) { PHASE_ARGS(); ln_phase(ap->out, WSB(WS_XB), ap->in[15] + l * D, ap->in[16] + l * D, gw, NGW, lane + zq); }
        SEAM(pb + 3);
        if (RUNJ(4)) { PHASE_ARGS(); EpiSwiglu E{WSB(WS_HFF), DFF}; run_gemm(lds, WSB(WS_XB), WSB(WS_WGU) + (size_t)l * 2 * DFF * D, 2 * DFF, D, E, G, bid); }
        SEAM(pb + 4);
        if (RUNJ(5)) { PHASE_ARGS(); EpiResid E{ap->out, ap->out, D, ALPHA}; run_gemm(lds, WSB(WS_HFF), WSB(WS_WD) + (size_t)l * D * DFF, D, DFF, E, G, bid); }
        SEAM(pb + 5);
        if (RUNJ(6)) { PHASE_ARGS(); ln_phase(ap->out, WSB(WS_XB), ap->in[20] + l * D, ap->in[21] + l * D, gw, NGW, lane + zq); }
        SEAM(pb + 6);
        if (RUNJ(7)) { PHASE_ARGS(); EpiPle E{ap->in[24] + l * D, WSB(WS_PP) + (size_t)l * M * D, ap->out, l == 0 ? WSB(WS_MIX) : (bf16*)nullptr}; run_gemm(lds, WSB(WS_XB), WSB(WS_WPG) + (size_t)l * D * D, D, D, E, G, bid); }
        SEAM(pb + 7);
    }
#undef RUN
#undef RUNJ
#undef SEAM
}

extern "C" void kernel_launch(void* const* d_in, const int* in_sizes, int n_in, void* d_out, int out_size, void* d_ws, size_t ws_size, hipStream_t stream) {
    static int grid = 0;
    if (grid == 0) {
        if (n_in != 25 || out_size != M * D || ws_size < WS_END) { fprintf(stderr, "kernel_launch: unexpected shapes (n_in %d, out %d, ws %zu)\n", n_in, out_size, ws_size); grid = -1; return; }
        int dev = 0, cus = 0, per_cu = 0;
        hipGetDevice(&dev); hipDeviceGetAttribute(&cus, hipDeviceAttributeMultiprocessorCount, dev);
        if (hipFuncSetAttribute((const void*)mega_fwd, hipFuncAttributeMaxDynamicSharedMemorySize, LDS_BYTES) != hipSuccess) { fprintf(stderr, "kernel_launch: hipFuncSetAttribute failed\n"); grid = -1; return; }
        if (hipOccupancyMaxActiveBlocksPerMultiprocessor(&per_cu, (const void*)mega_fwd, NT, LDS_BYTES) != hipSuccess || per_cu < 1) { fprintf(stderr, "kernel_launch: occupancy query gives %d\n", per_cu); per_cu = 1; }
        (void)hipGetLastError();
        grid = cus * (per_cu > 1 ? 1 : per_cu);
        fprintf(stderr, "kernel_launch: grid %d (cus %d, per_cu %d)\n", grid, cus, per_cu);
    }
    if (grid < 0) return;
    Args a{};
    for (int i = 0; i < 25; ++i) a.in[i] = (const float*)d_in[i];
    a.out = (float*)d_out; a.ws = (unsigned char*)d_ws;
#if MK_PER_PHASE
    for (int k = 0; k < N_PHASES; ++k) { a.ph_lo = k; a.ph_hi = k + 1; hipLaunchKernelGGL(mega_fwd, dim3(grid), dim3(NT), LDS_BYTES, stream, a); }
#else
    a.ph_lo = 0; a.ph_hi = N_PHASES;
    void* kargs[] = {&a};
    hipError_t e = hipLaunchCooperativeKernel((const void*)mega_fwd, dim3(grid), dim3(NT), kargs, LDS_BYTES, stream);
    if (e != hipSuccess) fprintf(stderr, "kernel_launch: cooperative launch failed: %s (grid %d)\n", hipGetErrorString(e), grid);
#endif
}
```

```cpp
#include <hip/hip_runtime.h>
#include <hip/hip_cooperative_groups.h>
#include <cstdio>
#include <cstdint>
namespace cg = cooperative_groups;
namespace pg8 {
#define PG8_LAS __attribute__((address_space(3)))
typedef unsigned short bf16_t;
typedef short bf16x8 __attribute__((ext_vector_type(8)));
typedef float f32x4 __attribute__((ext_vector_type(4)));
typedef unsigned u32x4 __attribute__((ext_vector_type(4)));
constexpr int BM = 256, BK = 64, HALF = 128, HTB = HALF * BK * 2  , STAGE_BYTES = 8 * HTB, NXCD = 8, WGM = 8;

__host__ __device__ __forceinline__ int lds_byte(int r, int c) { const int st = (r >> 4) * 2 + (c >> 5), rr = r & 15, cc = c & 31, ob = rr * 64 + cc * 2; return st * 1024 + (ob ^ (((ob >> 9) & 1) << 5)); }
__host__ __device__ __forceinline__ void stage_rc(int b, int& R, int& C) { const int st = b / 1024, sb = b % 1024, swz = sb ^ (((sb >> 9) & 1) << 5); R = (st >> 1) * 16 + swz / 64; C = (st & 1) * 32 + (swz % 64) / 2; }
__host__ __device__ __forceinline__ int perm32(int rho) { const int n = rho >> 4, i = rho & 15; return 8 * (i >> 2) + 4 * n + (i & 3); }

struct Unit { int pm, pn; };
struct Gemm { const bf16_t* A; const bf16_t* Bt; int M, N, K; };

struct StaticOrder {
    int nM, nN, nwg, G, c;
    __host__ __device__ void init(int M, int N, int G_, int c_) { nM = M / BM; nN = N / BM; nwg = nM * nN; G = G_; c = c_; }
    __host__ __device__ bool next(int i, Unit& u) const {
        const long L = (long)i * G + c; if (L >= nwg) return false;
        int wgid = (int)L; { const int q = nwg / NXCD, r = nwg % NXCD, xcd = wgid % NXCD, off = wgid / NXCD; wgid = (xcd < r ? xcd * (q + 1) : r * (q + 1) + (xcd - r) * q) + off; }
        const int nig = WGM * nN, gid = wgid / nig, fm = gid * WGM, gsz = (nM - fm) < WGM ? (nM - fm) : WGM;
        u.pm = fm + ((wgid % nig) % gsz); u.pn = (wgid % nig) / gsz; return true;
    }
    __device__ __forceinline__ void a_ready(const Unit&) const {}
    __device__ __forceinline__ void done(const Unit&) const {}
};

__device__ __forceinline__ unsigned cvt_pk_bf16(float lo, float hi) { unsigned r; asm volatile("v_cvt_pk_bf16_f32 %0, %1, %2" : "=v"(r) : "v"(lo), "v"(hi)); return r; }
typedef float f32x2 __attribute__((ext_vector_type(2)));
__device__ __forceinline__ f32x2 gelu_pk(f32x2 v) {
    const f32x2 av = __builtin_elementwise_abs(v), d = av * 0.2316418882f + 1.0f;
    f32x2 t; t.x = __builtin_amdgcn_rcpf(d.x); t.y = __builtin_amdgcn_rcpf(d.y);
    f32x2 q = t * 0.5307027145f + (-0.7265760135f); q = q * t + 0.7107068705f; q = q * t + (-0.142248368f); q = q * t + 0.127414796f; q = q * t;
    const f32x2 s = (v * v) * (-0.72134752044f);
    f32x2 e; e.x = __builtin_amdgcn_exp2f(s.x); e.y = __builtin_amdgcn_exp2f(s.y);
    const f32x2 m = v * (q * e), r = v - m;
    f32x2 o; o.x = v.x < 0.f ? m.x : r.x; o.y = v.y < 0.f ? m.y : r.y; return o;
}

template <int ACT  > struct EpiBf16 {
    static constexpr bool PERM = true, AFTER_DRAIN = false; static_assert(ACT == 0 || ACT == 1, "EpiBf16: ACT is 0 (none) or 1 (gelu_pk)");
    bf16_t* O; int ldc; const float* bias; int split_cols; size_t split_stride; float scale0;
    __device__ __forceinline__ void operator()(const f32x4 (&acc)[2][2][4][2], const Unit& u, int wr, int wc, int fr, int fq) const {
        const int row0 = u.pm * BM + wr * 64 + fr; int colt = u.pn * BM; bf16_t* base = O;
        float sc = 1.f; if (split_cols) { const int t = colt / split_cols; base += (size_t)t * split_stride; colt -= t * split_cols; if (t == 0) sc = scale0; }
        const int col0 = colt + wc * 32 + 8 * fq, bcol0 = u.pn * BM + wc * 32 + 8 * fq;
        f32x4 bv[2][2];
#pragma unroll
        for (int bj = 0; bj < 2; ++bj)
#pragma unroll
            for (int n = 0; n < 2; ++n) bv[bj][n] = bias ? *(const f32x4*)(bias + bcol0 + bj * HALF + 4 * n) : (f32x4){0.f, 0.f, 0.f, 0.f};
#pragma unroll
        for (int ai = 0; ai < 2; ++ai)
#pragma unroll
            for (int m = 0; m < 4; ++m) { bf16_t* rowp = base + (size_t)(row0 + ai * HALF + m * 16) * ldc + col0;
#pragma unroll
                for (int bj = 0; bj < 2; ++bj) { f32x4 v0 = acc[ai][bj][m][0] + bv[bj][0], v1 = acc[ai][bj][m][1] + bv[bj][1];
                    if (ACT == 1) { f32x2 a = gelu_pk((f32x2){v0[0], v0[1]}), b = gelu_pk((f32x2){v0[2], v0[3]}), c = gelu_pk((f32x2){v1[0], v1[1]}), d = gelu_pk((f32x2){v1[2], v1[3]});
                        v0 = (f32x4){a.x, a.y, b.x, b.y}; v1 = (f32x4){c.x, c.y, d.x, d.y}; }
                    v0 = v0 * sc; v1 = v1 * sc; u32x4 w; w.x = cvt_pk_bf16(v0[0], v0[1]); w.y = cvt_pk_bf16(v0[2], v0[3]); w.z = cvt_pk_bf16(v1[0], v1[1]); w.w = cvt_pk_bf16(v1[2], v1[3]);
                    *(u32x4*)(rowp + bj * HALF) = w; } }
    }
};

struct PanelStats {
    unsigned* xbuf;
    unsigned* cnt;
    unsigned* tmo;
    int ntn; float eps;
    unsigned code;
    __device__ __forceinline__ bool run(const f32x4 (&v)[2][2][4][2], const Unit& u, int wr, int wc, int fr, int fq, PG8_LAS unsigned char* lds, int wid, int lane) const {
        typedef float f32x2v __attribute__((ext_vector_type(2)));
        PG8_LAS f32x2v* P = (PG8_LAS f32x2v*)lds;
        PG8_LAS f32x2v* S = (PG8_LAS f32x2v*)(lds + 8192);
        PG8_LAS unsigned* flag = (PG8_LAS unsigned*)(lds + 8192 + 2048);
#pragma unroll
        for (int ai = 0; ai < 2; ++ai)
#pragma unroll
            for (int m = 0; m < 4; ++m) {
                float s = 0.f;
#pragma unroll
                for (int bj = 0; bj < 2; ++bj)
#pragma unroll
                    for (int n = 0; n < 2; ++n) { const f32x4 x = v[ai][bj][m][n]; s += (x[0] + x[1]) + (x[2] + x[3]); }
                s += __shfl_xor(s, 16); s += __shfl_xor(s, 32);
                const float mw = s * (1.0f / 64.0f); float q = 0.f;
#pragma unroll
                for (int bj = 0; bj < 2; ++bj)
#pragma unroll
                    for (int n = 0; n < 2; ++n) { const f32x4 d = v[ai][bj][m][n] - mw; q += (d[0] * d[0] + d[1] * d[1]) + (d[2] * d[2] + d[3] * d[3]); }
                q += __shfl_xor(q, 16); q += __shfl_xor(q, 32);
                if (fq == 0) P[(ai * HALF + wr * 64 + m * 16 + fr) * 4 + wc] = (f32x2v){mw, q};
            }
        asm volatile("s_waitcnt lgkmcnt(0)" ::: "memory"); __builtin_amdgcn_s_barrier(); asm volatile("" ::: "memory");
#if defined(BROKEN_EXCHANGE_NO_WAIT)
#warning BROKEN CONTROL BUILD: the row-statistics exchange does not wait; results are wrong by design
        if (blockIdx.x >= 64) { const long long t0_ = clock64(); while (clock64() - t0_ < 60000) __builtin_amdgcn_s_sleep(8); }
#endif
        const int row = wid * 32 + (lane & 31);
        if (lane < 32) {
            const f32x2v a = P[row * 4 + 0], b = P[row * 4 + 1], c = P[row * 4 + 2], d = P[row * 4 + 3];
            const float mt = (a.x + b.x + c.x + d.x) * 0.25f;
            const float da = a.x - mt, db = b.x - mt, dc = c.x - mt, dd = d.x - mt;
            const float m2 = (a.y + b.y) + (c.y + d.y) + 64.0f * ((da * da + db * db) + (dc * dc + dd * dd));
            unsigned long long* slot = (unsigned long long*)xbuf + ((size_t)(u.pm * BM + row) * 4 + u.pn);
            __hip_atomic_store(slot, ((unsigned long long)__float_as_uint(m2) << 32) | __float_as_uint(mt), __ATOMIC_RELAXED, __HIP_MEMORY_SCOPE_AGENT);
        }
        asm volatile("s_waitcnt vmcnt(0)" ::: "memory");
        if (lane == 0) __hip_atomic_fetch_add(cnt + 64 * u.pm, 1u, __ATOMIC_RELAXED, __HIP_MEMORY_SCOPE_AGENT);
        if (wid == 0) {
            bool dead = false; const unsigned long long t0 = __builtin_amdgcn_s_memrealtime(); const unsigned want = 8u * (unsigned)ntn;
            for (;;) {
#if defined(BROKEN_EXCHANGE_NO_WAIT)
                break;
#endif
                if ((unsigned)__builtin_amdgcn_readfirstlane(__hip_atomic_load(cnt + 64 * u.pm, __ATOMIC_RELAXED, __HIP_MEMORY_SCOPE_AGENT)) >= want) break;
                if (__builtin_amdgcn_s_memrealtime() - t0 > 2000000ull) {
                    if (lane == 0) { unsigned expect = 0u; __hip_atomic_compare_exchange_strong(tmo + 1, &expect, code | (unsigned)(u.pm & 0xff), __ATOMIC_RELAXED, __ATOMIC_RELAXED, __HIP_MEMORY_SCOPE_AGENT);
                                     __hip_atomic_store(tmo, 1u, __ATOMIC_RELAXED, __HIP_MEMORY_SCOPE_AGENT); }
                    dead = true; break; }
                __builtin_amdgcn_s_sleep(2);
            }
            __builtin_amdgcn_fence(__ATOMIC_ACQUIRE, "agent");
            if (lane == 0) flag[0] = dead ? 1u : 0u;
        }
        asm volatile("s_waitcnt vmcnt(0) lgkmcnt(0)" ::: "memory"); __builtin_amdgcn_s_barrier(); asm volatile("" ::: "memory");
        const bool bad = flag[0] != 0u;
        if (lane < 32) {
            const unsigned long long* slot = (const unsigned long long*)xbuf + (size_t)(u.pm * BM + row) * 4; float mt[4], m2[4]; float ms = 0.f;
#pragma unroll
            for (int t = 0; t < 4; ++t) { if (t < ntn) { const unsigned long long w = __hip_atomic_load(slot + t, __ATOMIC_RELAXED, __HIP_MEMORY_SCOPE_AGENT); mt[t] = __uint_as_float((unsigned)w); m2[t] = __uint_as_float((unsigned)(w >> 32)); } else { mt[t] = 0.f; m2[t] = 0.f; } ms += mt[t]; }
            const float mean = ms / (float)ntn; float q = 0.f;
#pragma unroll
            for (int t = 0; t < 4; ++t) if (t < ntn) { const float dm = mt[t] - mean; q += m2[t] + 256.0f * dm * dm; }
            S[row] = (f32x2v){mean, 1.0f / sqrtf(q / (256.0f * (float)ntn) + eps)};
        }
        asm volatile("s_waitcnt lgkmcnt(0)" ::: "memory"); __builtin_amdgcn_s_barrier(); asm volatile("" ::: "memory");
        return bad;
    }
};
struct EpiLnRes {
    static constexpr bool PERM = false, AFTER_DRAIN = true;
    const float* base; float* out; int ldc; const float* bias; PanelStats st; unsigned poison;
    __device__ __forceinline__ void fused(f32x4 (&acc)[2][2][4][2], const Unit& u, int wr, int wc, int fr, int fq, PG8_LAS unsigned char* lds, int wid, int lane) const {
        typedef float f32x2v __attribute__((ext_vector_type(2)));
        const PG8_LAS f32x2v* S = (const PG8_LAS f32x2v*)(lds + 8192);
        const int col0 = u.pn * BM + wc * 32 + 4 * fq;
#pragma unroll
        for (int bj = 0; bj < 2; ++bj)
#pragma unroll
            for (int n = 0; n < 2; ++n) { const f32x4 bv = bias ? *(const f32x4*)(bias + col0 + bj * HALF + n * 16) : (f32x4){0.f, 0.f, 0.f, 0.f};
#pragma unroll
                for (int ai = 0; ai < 2; ++ai)
#pragma unroll
                    for (int m = 0; m < 4; ++m) acc[ai][bj][m][n] += bv; }
        f32x4 pre[4][2][2];
#pragma unroll
        for (int m = 0; m < 4; ++m) { const size_t off = (size_t)(u.pm * BM + wr * 64 + m * 16 + fr) * ldc + col0;
#pragma unroll
            for (int bj = 0; bj < 2; ++bj)
#pragma unroll
                for (int n = 0; n < 2; ++n) pre[m][bj][n] = *(const f32x4*)(base + off + bj * HALF + n * 16); }
        const bool bad = st.run(acc, u, wr, wc, fr, fq, lds, wid, lane) || poison != 0u;
        const float qnan = __builtin_nanf("");
#pragma unroll
        for (int ai = 0; ai < 2; ++ai)
#pragma unroll
            for (int m = 0; m < 4; ++m) { const int r = ai * HALF + wr * 64 + m * 16 + fr; const f32x2v sr = S[r]; const size_t off = (size_t)(u.pm * BM + r) * ldc + col0;
#pragma unroll
                for (int bj = 0; bj < 2; ++bj)
#pragma unroll
                    for (int n = 0; n < 2; ++n) { const f32x4 bs = ai == 0 ? pre[m][bj][n] : *(const f32x4*)(base + off + bj * HALF + n * 16); f32x4 o = bs + (acc[ai][bj][m][n] - sr.x) * sr.y;
                        if (bad) o = (f32x4){qnan, qnan, qnan, qnan}; *(f32x4*)(out + off + bj * HALF + n * 16) = o; }
                if (m & 1) asm volatile("" ::: "memory"); }
    }
};
struct EpiLnResLn {
    static constexpr bool PERM = false, AFTER_DRAIN = true;
    const float* base; float* out; bf16_t* xn; int ldc; const float* bias; PanelStats st1, st2; unsigned poison;
    __device__ __forceinline__ void fused(f32x4 (&acc)[2][2][4][2], const Unit& u, int wr, int wc, int fr, int fq, PG8_LAS unsigned char* lds, int wid, int lane) const {
        typedef float f32x2v __attribute__((ext_vector_type(2))); typedef unsigned u32x2v __attribute__((ext_vector_type(2)));
        const PG8_LAS f32x2v* S = (const PG8_LAS f32x2v*)(lds + 8192);
        const int col0 = u.pn * BM + wc * 32 + 4 * fq;
#pragma unroll
        for (int bj = 0; bj < 2; ++bj)
#pragma unroll
            for (int n = 0; n < 2; ++n) { const f32x4 bv = bias ? *(const f32x4*)(bias + col0 + bj * HALF + n * 16) : (f32x4){0.f, 0.f, 0.f, 0.f};
#pragma unroll
                for (int ai = 0; ai < 2; ++ai)
#pragma unroll
                    for (int m = 0; m < 4; ++m) acc[ai][bj][m][n] += bv; }
        bool bad = st1.run(acc, u, wr, wc, fr, fq, lds, wid, lane) || poison != 0u;
        const float qnan = __builtin_nanf("");
#pragma unroll
        for (int ai = 0; ai < 2; ++ai)
#pragma unroll
            for (int m = 0; m < 4; ++m) { const int r = ai * HALF + wr * 64 + m * 16 + fr; const f32x2v sr = S[r]; const size_t off = (size_t)(u.pm * BM + r) * ldc + col0;
#pragma unroll
                for (int bj = 0; bj < 2; ++bj)
#pragma unroll
                    for (int n = 0; n < 2; ++n) { const f32x4 bs = *(const f32x4*)(base + off + bj * HALF + n * 16); acc[ai][bj][m][n] = bs + (acc[ai][bj][m][n] - sr.x) * sr.y; }
                asm volatile("" : "+v"(acc[ai][0][m][0]), "+v"(acc[ai][0][m][1]), "+v"(acc[ai][1][m][0]), "+v"(acc[ai][1][m][1]));
                if (m & 1) asm volatile("" ::: "memory"); }
        const bool bad1 = bad;
        bad = st2.run(acc, u, wr, wc, fr, fq, lds, wid, lane) || bad;
#pragma unroll
        for (int ai = 0; ai < 2; ++ai)
#pragma unroll
            for (int m = 0; m < 4; ++m) { const int r = ai * HALF + wr * 64 + m * 16 + fr; const f32x2v sr = S[r]; const size_t off = (size_t)(u.pm * BM + r) * ldc + col0;
#pragma unroll
                for (int bj = 0; bj < 2; ++bj)
#pragma unroll
                    for (int n = 0; n < 2; ++n) { const f32x4 x1 = acc[ai][bj][m][n]; *(f32x4*)(out + off + bj * HALF + n * 16) = bad1 ? (f32x4){qnan, qnan, qnan, qnan} : x1;
                        const f32x4 o = (x1 - sr.x) * sr.y; u32x2v w; w.x = cvt_pk_bf16(o[0], o[1]); w.y = cvt_pk_bf16(o[2], o[3]);
                        if (bad) { w.x = 0x7fc07fc0u; w.y = 0x7fc07fc0u; } *(u32x2v*)(xn + off + bj * HALF + n * 16) = w; }
                asm volatile("" ::: "memory"); }
    }
};

template <class Epi, class Sched, bool ALIGN_EPI = false, bool SP2 = false>
__device__ __forceinline__ void gemm_phase(PG8_LAS unsigned char* lds, const Gemm g, const Sched& S, const Epi& E) {
    const int tid = threadIdx.x, wid = __builtin_amdgcn_readfirstlane(tid >> 6), lane = tid & 63, wr = wid >> 2, wc = wid & 3, fr = lane & 15, fq = lane >> 4;
    const int K = g.K, nt = K / BK;
    unsigned voffA[2], voffB[2];
#pragma unroll
    for (int i = 0; i < 2; ++i) { int R, C; stage_rc(tid * 16 + i * 8192, R, C); const int Rb = Epi::PERM ? ((R & ~31) + perm32(R & 31)) : R;
        voffA[i] = (unsigned)(R * K + C) * 2u; voffB[i] = (unsigned)(Rb * K + C) * 2u; }
    const size_t kstep = (size_t)(BK * 2);
    const size_t hstep = (size_t)HALF * K * 2;
    const size_t tstep = 2 * hstep;
    const unsigned ldsw = (unsigned)wid * 1024u;
    const int aoff = lds_byte(wr * 64 + fr, fq * 8), boff = lds_byte(wc * 32 + fr, fq * 8);
#define PG8_SA(b, h) (((b) * 2 + (h)) * HTB)
#define PG8_SB(b, h) ((4 + (b) * 2 + (h)) * HTB)
#define PG8_STAGE(bufoff, gbase, voff) do { _Pragma("unroll") for (int _i = 0; _i < 2; ++_i) \
        __builtin_amdgcn_global_load_lds((const unsigned*)((const char*)(gbase) + (voff)[_i]), (PG8_LAS unsigned*)(lds + (bufoff) + ldsw + _i * 8192), 16, 0, 0); } while (0)
#define PG8_LDA(dst, b, h) do { _Pragma("unroll") for (int m = 0; m < 4; ++m) _Pragma("unroll") for (int k = 0; k < 2; ++k) dst[m][k] = *(const PG8_LAS bf16x8*)(lds + PG8_SA(b, h) + aoff + m * 2048 + k * 1024); } while (0)
#define PG8_LDB(dst, b, h) do { _Pragma("unroll") for (int n = 0; n < 2; ++n) _Pragma("unroll") for (int k = 0; k < 2; ++k) dst[n][k] = *(const PG8_LAS bf16x8*)(lds + PG8_SB(b, h) + boff + n * 2048 + k * 1024); } while (0)
#define PG8_MMA(ai, bj, At, Bt) do { __builtin_amdgcn_s_setprio(1); _Pragma("unroll") for (int m = 0; m < 4; ++m) _Pragma("unroll") for (int n = 0; n < 2; ++n) _Pragma("unroll") for (int k = 0; k < 2; ++k) \
        acc[ai][bj][m][n] = __builtin_amdgcn_mfma_f32_16x16x32_bf16(Bt[n][k], At[m][k], acc[ai][bj][m][n], 0, 0, 0); __builtin_amdgcn_s_setprio(0); } while (0)
#define PG8_WAIT_V(n) asm volatile("s_waitcnt vmcnt(" #n ")" ::: "memory")
#define PG8_WAIT_L(n) asm volatile("s_waitcnt lgkmcnt(" #n ")" ::: "memory")
#define PG8_BAR __builtin_amdgcn_s_barrier()
#define PG8_SCHED __builtin_amdgcn_sched_barrier(0)
    Unit cur, nxt; int ui = 0;
    if (!S.next(0, cur)) return;
    f32x4 acc[2][2][4][2];
#pragma unroll
    for (int a = 0; a < 2; ++a)
#pragma unroll
        for (int b = 0; b < 2; ++b)
#pragma unroll
            for (int m = 0; m < 4; ++m)
#pragma unroll
                for (int n = 0; n < 2; ++n) acc[a][b][m][n] = (f32x4){0.f, 0.f, 0.f, 0.f};
    bf16x8 At[4][2], B0[2][2], B1[2][2];
    const char* cA = (const char*)g.A + (size_t)cur.pm * tstep; const char* cB = (const char*)g.Bt + (size_t)cur.pn * tstep;
    S.a_ready(cur);
    if constexpr (SP2) {
        PG8_STAGE(PG8_SB(0, 0), cB, voffB); PG8_STAGE(PG8_SB(0, 1), cB + hstep, voffB); PG8_STAGE(PG8_SA(0, 0), cA, voffA); PG8_STAGE(PG8_SA(0, 1), cA + hstep, voffA);
        if (wr == 1) PG8_BAR;
        PG8_WAIT_V(2); PG8_BAR;
        PG8_STAGE(PG8_SB(1, 0), cB + kstep, voffB); PG8_STAGE(PG8_SA(1, 0), cA + kstep, voffA); PG8_STAGE(PG8_SB(1, 1), cB + hstep + kstep, voffB);
        PG8_WAIT_V(6); PG8_BAR;
    } else {
        PG8_STAGE(PG8_SB(0, 0), cB, voffB); PG8_STAGE(PG8_SA(0, 0), cA, voffA); PG8_STAGE(PG8_SB(0, 1), cB + hstep, voffB); PG8_STAGE(PG8_SA(0, 1), cA + hstep, voffA);
        if (wr == 1) PG8_BAR;
        PG8_WAIT_V(4); PG8_BAR;
        PG8_STAGE(PG8_SB(1, 0), cB + kstep, voffB); PG8_STAGE(PG8_SA(1, 0), cA + kstep, voffA); PG8_STAGE(PG8_SB(1, 1), cB + hstep + kstep, voffB);
        PG8_WAIT_V(6); PG8_BAR;
    }
    for (;;) {
        const bool has_next = S.next(ui + 1, nxt);
        const char* nA = has_next ? (const char*)g.A + (size_t)nxt.pm * tstep : cA; const char* nB = has_next ? (const char*)g.Bt + (size_t)nxt.pn * tstep : cB;
        for (int t = 0; t < nt; t += 2) {
            const bool last = (t == nt - 2);
            const char* a1 = cA + (size_t)(t + 1) * kstep;
            const char* a2 = last ? nA : cA + (size_t)(t + 2) * kstep; const char* b2 = last ? nB : cB + (size_t)(t + 2) * kstep;
            const char* a3 = a2 + kstep; const char* b3 = b2 + kstep;
            if (last && has_next) S.a_ready(nxt);
            if constexpr (SP2) {
            PG8_LDB(B0, 0, 0); PG8_LDB(B1, 0, 1); PG8_SCHED; PG8_LDA(At, 0, 0); PG8_STAGE(PG8_SA(1, 1), a1 + hstep, voffA);
            PG8_WAIT_V(8); PG8_WAIT_L(0); PG8_BAR; PG8_MMA(0, 0, At, B0); PG8_MMA(0, 1, At, B1); PG8_BAR; PG8_SCHED;
            PG8_LDA(At, 0, 1); PG8_STAGE(PG8_SB(0, 0), b2, voffB); PG8_STAGE(PG8_SB(0, 1), b2 + hstep, voffB); PG8_STAGE(PG8_SA(0, 0), a2, voffA);
            PG8_WAIT_V(8); PG8_WAIT_L(0); PG8_BAR; PG8_MMA(1, 0, At, B0); PG8_MMA(1, 1, At, B1); PG8_BAR; PG8_SCHED;
            PG8_LDB(B0, 1, 0); PG8_LDB(B1, 1, 1); PG8_SCHED; PG8_LDA(At, 1, 0); PG8_STAGE(PG8_SA(0, 1), a2 + hstep, voffA);
            PG8_WAIT_V(8); PG8_WAIT_L(0); PG8_BAR; PG8_MMA(0, 0, At, B0); PG8_MMA(0, 1, At, B1); PG8_BAR; PG8_SCHED;
            PG8_LDA(At, 1, 1); PG8_STAGE(PG8_SB(1, 0), b3, voffB); PG8_STAGE(PG8_SB(1, 1), b3 + hstep, voffB); PG8_STAGE(PG8_SA(1, 0), a3, voffA);
            PG8_WAIT_V(8); PG8_WAIT_L(0); PG8_BAR; PG8_MMA(1, 0, At, B0); PG8_MMA(1, 1, At, B1); PG8_BAR; PG8_SCHED;
            } else {
            PG8_LDB(B0, 0, 0); PG8_SCHED; PG8_LDA(At, 0, 0); PG8_STAGE(PG8_SA(1, 1), a1 + hstep, voffA);
            PG8_WAIT_L(8); PG8_BAR; PG8_WAIT_L(0); PG8_MMA(0, 0, At, B0); PG8_BAR; PG8_SCHED;
            PG8_LDB(B1, 0, 1); PG8_STAGE(PG8_SB(0, 0), b2, voffB);
            PG8_BAR; PG8_WAIT_L(0); PG8_MMA(0, 1, At, B1); PG8_BAR;
            PG8_LDA(At, 0, 1); PG8_STAGE(PG8_SA(0, 0), a2, voffA);
            PG8_BAR; PG8_WAIT_L(0); PG8_MMA(1, 0, At, B0); PG8_BAR; PG8_SCHED;
            PG8_STAGE(PG8_SB(0, 1), b2 + hstep, voffB);
            PG8_WAIT_V(6); PG8_BAR; PG8_MMA(1, 1, At, B1); PG8_BAR;
            PG8_LDB(B0, 1, 0); PG8_SCHED; PG8_LDA(At, 1, 0); PG8_STAGE(PG8_SA(0, 1), a2 + hstep, voffA);
            PG8_WAIT_L(8); PG8_BAR; PG8_WAIT_L(0); PG8_MMA(0, 0, At, B0); PG8_BAR; PG8_SCHED;
            PG8_LDB(B1, 1, 1); PG8_STAGE(PG8_SB(1, 0), b3, voffB);
            PG8_BAR; PG8_WAIT_L(0); PG8_MMA(0, 1, At, B1); PG8_BAR;
            PG8_LDA(At, 1, 1); PG8_STAGE(PG8_SA(1, 0), a3, voffA);
            PG8_BAR; PG8_WAIT_L(0); PG8_MMA(1, 0, At, B0); PG8_BAR; PG8_SCHED;
            PG8_STAGE(PG8_SB(1, 1), b3 + hstep, voffB);
            PG8_WAIT_V(6); PG8_BAR; PG8_MMA(1, 1, At, B1); PG8_BAR;
            }
        }
        if constexpr (ALIGN_EPI) { if (wr == 0) PG8_BAR; }
        if constexpr (!Epi::AFTER_DRAIN) { E(acc, cur, wr, wc, fr, fq); S.done(cur); }
        if (!has_next) break;
#pragma unroll
        for (int a = 0; a < 2; ++a)
#pragma unroll
            for (int b = 0; b < 2; ++b)
#pragma unroll
                for (int m = 0; m < 4; ++m)
#pragma unroll
                    for (int n = 0; n < 2; ++n) acc[a][b][m][n] = (f32x4){0.f, 0.f, 0.f, 0.f};
        cur = nxt; cA = nA; cB = nB; ++ui;
        if constexpr (ALIGN_EPI) { if (wr == 1) PG8_BAR; }
    }
    PG8_WAIT_V(0);
    if constexpr (!ALIGN_EPI) { if (wr == 0) PG8_BAR; }
    PG8_BAR;
    if constexpr (Epi::AFTER_DRAIN) { E.fused(acc, cur, wr, wc, fr, fq, lds, wid, lane); S.done(cur); }
#undef PG8_SA
#undef PG8_SB
#undef PG8_STAGE
#undef PG8_LDA
#undef PG8_LDB
#undef PG8_MMA
#undef PG8_WAIT_V
#undef PG8_WAIT_L
#undef PG8_BAR
#undef PG8_SCHED
}
}
#define LAS __attribute__((address_space(3)))
typedef unsigned short bf16;
typedef unsigned v4u __attribute__((ext_vector_type(4)));
typedef unsigned v2u __attribute__((ext_vector_type(2)));
typedef float f32x4 __attribute__((ext_vector_type(4)));
using pg8::bf16_t;

constexpr int NWAVES = 8, NT = 512;
constexpr int BATCH = 8, SEQ = 2048, M = BATCH * SEQ, D = 1024, DIN = 2048, DFF = 2816, PLE = 256;
constexpr float ALPHA = 1.4142135623730951f, LN_EPS = 1e-5f;
constexpr int N_PHASES = 17;
#ifndef MK_PER_PHASE
#define MK_PER_PHASE 0
#endif

constexpr size_t MiB = 1u << 20;
constexpr size_t WS_WIN = 1 * MiB, WS_WOUT = 9 * MiB, WS_WGU = 13 * MiB, WS_WD = 35 * MiB, WS_WPG = 46 * MiB, WS_WPP = 50 * MiB;
constexpr size_t WS_POOLWT = 51 * MiB, WS_SGW = 51 * MiB + 131072;
constexpr size_t WS_XB = 52 * MiB, WS_PP = 84 * MiB, WS_H = 148 * MiB, WS_MIX = 212 * MiB, WS_HFF = 148 * MiB, WS_END = 244 * MiB;
constexpr int LDS_BYTES = 135168;

#define LDS_WAIT() asm volatile("s_waitcnt lgkmcnt(0)" ::: "memory")
__device__ __forceinline__ unsigned f2bf(float f) { unsigned u = __builtin_bit_cast(unsigned, f); return (u + 0x7fffu + ((u >> 16) & 1u)) >> 16; }
__device__ __forceinline__ unsigned pk2(float lo, float hi) { return f2bf(lo) | (f2bf(hi) << 16); }
__device__ __forceinline__ float bf2f(bf16 v) { return __builtin_bit_cast(float, (unsigned)v << 16); }
__device__ __forceinline__ float bflo(unsigned w) { return __builtin_bit_cast(float, w << 16); }
__device__ __forceinline__ float bfhi(unsigned w) { return __builtin_bit_cast(float, w & 0xffff0000u); }
__device__ __forceinline__ float rl(float v, int l) { return __builtin_bit_cast(float, __builtin_amdgcn_readlane(__builtin_bit_cast(int, v), l)); }
__device__ __forceinline__ float fast_exp(float x) { return __builtin_amdgcn_exp2f(x * 1.4426950408889634f); }
__device__ __forceinline__ float sigmoidf_(float x) { return __builtin_amdgcn_rcpf(1.0f + fast_exp(-x)); }
__device__ __forceinline__ float siluf_(float x) { return x * sigmoidf_(x); }
__device__ __forceinline__ float softplusf_(float z) { return fmaxf(z, 0.f) + 0.6931471805599453f * __builtin_amdgcn_logf(1.0f + fast_exp(-fabsf(z))); }
__device__ __forceinline__ float gelu_tanh(float x) { const float y2 = 1.5957691216057308f * (x + 0.044715f * x * x * x); return x * sigmoidf_(y2); }
__device__ __forceinline__ float wave_sum(float v) {
#pragma unroll
    for (int o = 1; o < 64; o <<= 1) v += __shfl_xor(v, o);
    return v;
}

using pg8::Unit; using pg8::HALF; using pg8::BM;
struct EpiSwiglu {
    static constexpr bool PERM = true, AFTER_DRAIN = false;
    bf16_t* O; int ldc;
    __device__ __forceinline__ void operator()(const pg8::f32x4 (&acc)[2][2][4][2], const Unit& u, int wr, int wc, int fr, int fq) const {
        const int row0 = u.pm * BM + wr * 64 + fr, col0 = u.pn * HALF + wc * 32 + 8 * fq;
#pragma unroll
        for (int ai = 0; ai < 2; ++ai)
#pragma unroll
            for (int m = 0; m < 4; ++m) {
                bf16_t* rowp = O + (size_t)(row0 + ai * HALF + m * 16) * ldc + col0;
                const pg8::f32x4 g0 = acc[ai][0][m][0], g1 = acc[ai][0][m][1], u0 = acc[ai][1][m][0], u1 = acc[ai][1][m][1];
                pg8::u32x4 w;
                w.x = pg8::cvt_pk_bf16(siluf_(g0[0]) * u0[0], siluf_(g0[1]) * u0[1]); w.y = pg8::cvt_pk_bf16(siluf_(g0[2]) * u0[2], siluf_(g0[3]) * u0[3]);
                w.z = pg8::cvt_pk_bf16(siluf_(g1[0]) * u1[0], siluf_(g1[1]) * u1[1]); w.w = pg8::cvt_pk_bf16(siluf_(g1[2]) * u1[2], siluf_(g1[3]) * u1[3]);
                *(pg8::u32x4*)rowp = w;
            }
    }
};
struct EpiResid {
    static constexpr bool PERM = false, AFTER_DRAIN = false;
    const float* base; float* out; int ldc; float alpha;
    __device__ __forceinline__ void operator()(const pg8::f32x4 (&acc)[2][2][4][2], const Unit& u, int wr, int wc, int fr, int fq) const {
        const int col0 = u.pn * BM + wc * 32 + 4 * fq;
#pragma unroll
        for (int ai = 0; ai < 2; ++ai)
#pragma unroll
            for (int m = 0; m < 4; ++m) {
                const size_t off = (size_t)(u.pm * BM + ai * HALF + wr * 64 + m * 16 + fr) * ldc + col0;
#pragma unroll
                for (int bj = 0; bj < 2; ++bj)
#pragma unroll
                    for (int n = 0; n < 2; ++n) { const size_t o = off + bj * HALF + n * 16; const pg8::f32x4 bs = *(const pg8::f32x4*)(base + o); *(pg8::f32x4*)(out + o) = bs * alpha + acc[ai][bj][m][n]; }
                asm volatile("" ::: "memory");
            }
    }
};
struct EpiPle {
    static constexpr bool PERM = false, AFTER_DRAIN = false;
    const float* bias; const bf16_t* pp; float* xf; bf16_t* xb;
    __device__ __forceinline__ void operator()(const pg8::f32x4 (&acc)[2][2][4][2], const Unit& u, int wr, int wc, int fr, int fq) const {
        const int col0 = u.pn * BM + wc * 32 + 4 * fq;
        pg8::f32x4 bv[2][2];
#pragma unroll
        for (int bj = 0; bj < 2; ++bj)
#pragma unroll
            for (int n = 0; n < 2; ++n) bv[bj][n] = *(const pg8::f32x4*)(bias + col0 + bj * HALF + n * 16);
#pragma unroll
        for (int ai = 0; ai < 2; ++ai)
#pragma unroll
            for (int m = 0; m < 4; ++m) {
                const size_t off = (size_t)(u.pm * BM + ai * HALF + wr * 64 + m * 16 + fr) * D + col0;
#pragma unroll
                for (int bj = 0; bj < 2; ++bj)
#pragma unroll
                    for (int n = 0; n < 2; ++n) {
                        const size_t o = off + bj * HALF + n * 16;
                        const pg8::f32x4 x2 = *(const pg8::f32x4*)(xf + o); const v2u pw = *(const v2u*)(pp + o);
                        const pg8::f32x4 a = acc[ai][bj][m][n] + bv[bj][n];
                        pg8::f32x4 r;
                        r[0] = x2[0] + sigmoidf_(a[0]) * bflo(pw.x); r[1] = x2[1] + sigmoidf_(a[1]) * bfhi(pw.x);
                        r[2] = x2[2] + sigmoidf_(a[2]) * bflo(pw.y); r[3] = x2[3] + sigmoidf_(a[3]) * bfhi(pw.y);
                        *(pg8::f32x4*)(xf + o) = r;
                        if (xb) { v2u w; w.x = pg8::cvt_pk_bf16(r[0], r[1]); w.y = pg8::cvt_pk_bf16(r[2], r[3]); *(v2u*)(xb + o) = w; }
                    }
                asm volatile("" ::: "memory");
            }
    }
};


struct EpiInProj {
    static constexpr bool PERM = true, AFTER_DRAIN = false;
    bf16_t* O; bf16_t* VT;
    __device__ __forceinline__ void operator()(const pg8::f32x4 (&acc)[2][2][4][2], const Unit& u, int wr, int wc, int fr, int fq) const {
        const int row0 = u.pm * BM + wr * 64 + fr, col0 = u.pn * BM + wc * 32 + 8 * fq;
        if (VT != nullptr && (u.pn == 4 || u.pn == 5)) {
#pragma unroll
            for (int ai = 0; ai < 2; ++ai)
#pragma unroll
                for (int m = 0; m < 4; ++m) { const int r = row0 + ai * HALF + m * 16, b = r >> 11, t = r & (SEQ - 1);
#pragma unroll
                    for (int bj = 0; bj < 2; ++bj) { bf16_t* vp = VT + ((size_t)b * 512 + (col0 - 1024 + bj * HALF)) * SEQ + t;
#pragma unroll
                        for (int n = 0; n < 2; ++n)
#pragma unroll
                            for (int e = 0; e < 4; ++e) vp[(size_t)(4 * n + e) * SEQ] = (bf16_t)f2bf(acc[ai][bj][m][n][e]); } }
        } else {
#pragma unroll
            for (int ai = 0; ai < 2; ++ai)
#pragma unroll
                for (int m = 0; m < 4; ++m) { bf16_t* rowp = O + (size_t)(row0 + ai * HALF + m * 16) * DIN + col0;
#pragma unroll
                    for (int bj = 0; bj < 2; ++bj) { const pg8::f32x4 v0 = acc[ai][bj][m][0], v1 = acc[ai][bj][m][1]; pg8::u32x4 w;
                        w.x = pg8::cvt_pk_bf16(v0[0], v0[1]); w.y = pg8::cvt_pk_bf16(v0[2], v0[3]); w.z = pg8::cvt_pk_bf16(v1[0], v1[1]); w.w = pg8::cvt_pk_bf16(v1[2], v1[3]);
                        *(pg8::u32x4*)(rowp + bj * HALF) = w; } }
        }
    }
};

template <class Epi>
__device__ __forceinline__ void run_gemm(LAS unsigned char* lds, const bf16_t* A, const bf16_t* Bt, int N, int K, const Epi& E, int G, int bid) {
    int zq = 0; asm volatile("s_mov_b32 %0, 0" : "=s"(zq));
    K += zq; N += zq;
    pg8::Gemm g{A, Bt, M, N, K}; pg8::StaticOrder S; S.init(M, N, G, bid);
    pg8::gemm_phase<Epi, pg8::StaticOrder, true, true>(lds, g, S, E);
}

__device__ __forceinline__ void transpose_item(const float* W, int K, int N, bf16* WT, int kb, int n0, int dst_row0, LAS float* scr, int lane) {
    const int k0 = 64 * kb;
#pragma unroll 8
    for (int i = 0; i < 32; ++i) { const int kk = 2 * i + (lane >> 5); scr[kk * 33 + (lane & 31)] = W[(size_t)(k0 + kk) * N + n0 + (lane & 31)]; }
    LDS_WAIT();
    const int c = lane & 7;
#pragma unroll
    for (int j = 0; j < 4; ++j) { const int n = (lane >> 3) + 8 * j; const LAS float* s = scr + (8 * c) * 33 + n;
        v4u o; o.x = pk2(s[0 * 33], s[1 * 33]); o.y = pk2(s[2 * 33], s[3 * 33]); o.z = pk2(s[4 * 33], s[5 * 33]); o.w = pk2(s[6 * 33], s[7 * 33]);
        *(v4u*)(WT + (size_t)(dst_row0 + n) * K + k0 + 8 * c) = o; }
    LDS_WAIT();
}
__device__ __forceinline__ void cvt_f32_bf16(const float* src, bf16* dst, size_t n8, size_t gtid, size_t gthreads) {
    for (size_t i = gtid; i < n8; i += gthreads) {
        const f32x4 a = ((const f32x4*)src)[2 * i], b = ((const f32x4*)src)[2 * i + 1];
        v4u o; o.x = pk2(a[0], a[1]); o.y = pk2(a[2], a[3]); o.z = pk2(b[0], b[1]); o.w = pk2(b[2], b[3]);
        ((v4u*)dst)[i] = o;
    }
}
__device__ __forceinline__ void ln_phase(float* buf, bf16* xb, const float* g, const float* b, int gw, int NGW, int lane) {
    for (int m = gw; m < M; m += NGW) {
        f32x4* xr = (f32x4*)(buf + (size_t)m * D) + lane;
        f32x4 v[4]; float s = 0.f;
#pragma unroll
        for (int j = 0; j < 4; ++j) { v[j] = xr[64 * j]; s += (v[j][0] + v[j][1]) + (v[j][2] + v[j][3]); }
        const float mean = wave_sum(s) * (1.f / D); float s2 = 0.f;
#pragma unroll
        for (int j = 0; j < 4; ++j) { v[j] = v[j] - mean; s2 += (v[j][0] * v[j][0] + v[j][1] * v[j][1]) + (v[j][2] * v[j][2] + v[j][3] * v[j][3]); }
        const float rstd = 1.f / sqrtf(wave_sum(s2) * (1.f / D) + LN_EPS);
        v2u* o8 = (v2u*)(xb + (size_t)m * D) + lane;
#pragma unroll
        for (int j = 0; j < 4; ++j) {
            const f32x4 gg = ((const f32x4*)g)[lane + 64 * j], bb = ((const f32x4*)b)[lane + 64 * j];
            const f32x4 o = v[j] * rstd * gg + bb;
            xr[64 * j] = o; v2u w; w.x = pk2(o[0], o[1]); w.y = pk2(o[2], o[3]); o8[64 * j] = w;
        }
    }
}

__device__ __forceinline__ void attn_simple(const bf16* Hb, bf16* MIX, int gw, int NGW, int lane) {
    for (int item = gw; item < BATCH * 8 * SEQ; item += NGW) {
        const int t = item & (SEQ - 1), bh = item >> 11, b = bh >> 3, h = bh & 7;
        const bf16* base = Hb + (size_t)b * SEQ * DIN + h * 64;
        const float qv = bf2f(base[(size_t)t * DIN + lane]) * 0.125f;
        float o = 0.f, carry = 0.f;
        for (int hi = t; hi > 0; hi -= 64) {
            const int s = hi - 64 + lane; const bool valid = s >= 0; const int sc = valid ? s : 0;
            const bf16* krow = base + (size_t)sc * DIN + 512;
            float z = 0.f;
#pragma unroll
            for (int i = 0; i < 8; ++i) { const v4u kk = *(const v4u*)(krow + 8 * i);
                z += rl(qv, 8 * i + 0) * bflo(kk.x); z += rl(qv, 8 * i + 1) * bfhi(kk.x); z += rl(qv, 8 * i + 2) * bflo(kk.y); z += rl(qv, 8 * i + 3) * bfhi(kk.y);
                z += rl(qv, 8 * i + 4) * bflo(kk.z); z += rl(qv, 8 * i + 5) * bfhi(kk.z); z += rl(qv, 8 * i + 6) * bflo(kk.w); z += rl(qv, 8 * i + 7) * bfhi(kk.w); }
            const float L = valid ? -softplusf_(z) : 0.f;
            float R = L;
#pragma unroll
            for (int off = 1; off < 64; off <<= 1) { const float tmp = __shfl_down(R, off); if (lane + off < 64) R += tmp; }
            const float tot = rl(R, 0);
            const float w = valid ? fast_exp(z + R + carry) : 0.f;
            carry += tot;
#pragma unroll 16
            for (int j = 0; j < 64; ++j) { const float wj = __shfl(w, j); int sj = hi - 64 + j; sj = sj < 0 ? 0 : sj;
                o += wj * bf2f(base[(size_t)sj * DIN + 1024 + lane]); }
            if (carry < -110.f) break;
        }
        MIX[((size_t)b * SEQ + t) * D + h * 64 + lane] = (bf16)f2bf(o);
    }
}

typedef short bf16x8v __attribute__((ext_vector_type(8)));
typedef float f32x16 __attribute__((ext_vector_type(16)));
__device__ __forceinline__ void attn_mfma(const bf16* Hb, const bf16* VT, bf16* MIX, int gw, int NGW, int lane) {
    const int ln = lane & 31, hi = lane >> 5;
    bf16x8v tri[2];
#pragma unroll
    for (int ks2 = 0; ks2 < 2; ++ks2)
#pragma unroll
        for (int e = 0; e < 8; ++e) { const int j = 16 * ks2 + 8 * (e >> 2) + 4 * hi + (e & 3); tri[ks2][e] = (j >= ln) ? (short)0x3F80 : (short)0; }
    for (int item = gw; item < 64 * 64; item += NGW) {
        const int qb = item & 63, bh = item >> 6, b = bh >> 3, h = bh & 7;
        const int t0 = qb * 32, t = t0 + ln;
        const bf16* qp = Hb + ((size_t)(b * SEQ + t)) * DIN + h * 64 + 8 * hi;
        bf16x8v qf[4];
#pragma unroll
        for (int ks = 0; ks < 4; ++ks) qf[ks] = *(const bf16x8v*)(qp + 16 * ks);
        f32x16 o0, o1;
#pragma unroll
        for (int r = 0; r < 16; ++r) { o0[r] = 0.f; o1[r] = 0.f; }
        float cr = 0.f;
        const bf16* kbase = Hb + (size_t)b * SEQ * DIN + 512 + h * 64 + 8 * hi;
        const bf16* vbase = VT + ((size_t)(bh * 64 + ln)) * SEQ + 4 * hi;
        for (int sb = t0; sb >= 0; sb -= 32) {
            const bf16* kp = kbase + (size_t)(sb + ln) * DIN;
            bf16x8v kf[4];
#pragma unroll
            for (int ks = 0; ks < 4; ++ks) kf[ks] = *(const bf16x8v*)(kp + 16 * ks);
            v2u va[2][2], vb[2][2];
#pragma unroll
            for (int db = 0; db < 2; ++db)
#pragma unroll
                for (int ks2 = 0; ks2 < 2; ++ks2) { const bf16* vp = vbase + (size_t)db * 32 * SEQ + sb + 16 * ks2; va[db][ks2] = *(const v2u*)vp; vb[db][ks2] = *(const v2u*)(vp + 8); }
            f32x16 st;
#pragma unroll
            for (int r = 0; r < 16; ++r) st[r] = 0.f;
#pragma unroll
            for (int ks = 0; ks < 4; ++ks) st = __builtin_amdgcn_mfma_f32_32x32x16_bf16(kf[ks], qf[ks], st, 0, 0, 0);
            unsigned hb[16], lb[16]; float zz[16];
#pragma unroll
            for (int r = 0; r < 16; ++r) {
                const int key = sb + 8 * (r >> 2) + 4 * hi + (r & 3); const bool valid = key < t;
                zz[r] = st[r] * 0.125f;
                const float L = valid ? -softplusf_(zz[r]) : 0.f;
                hb[r] = f2bf(L); lb[r] = f2bf(L - __builtin_bit_cast(float, hb[r] << 16));
            }
            bf16x8v Bh[2], Bl[2];
#pragma unroll
            for (int ks2 = 0; ks2 < 2; ++ks2)
#pragma unroll
                for (int e = 0; e < 8; ++e) { Bh[ks2][e] = (short)hb[8 * ks2 + e]; Bl[ks2][e] = (short)lb[8 * ks2 + e]; }
            f32x16 R;
#pragma unroll
            for (int r = 0; r < 16; ++r) R[r] = cr;
            R = __builtin_amdgcn_mfma_f32_32x32x16_bf16(tri[0], Bh[0], R, 0, 0, 0);
            R = __builtin_amdgcn_mfma_f32_32x32x16_bf16(tri[1], Bh[1], R, 0, 0, 0);
            R = __builtin_amdgcn_mfma_f32_32x32x16_bf16(tri[0], Bl[0], R, 0, 0, 0);
            R = __builtin_amdgcn_mfma_f32_32x32x16_bf16(tri[1], Bl[1], R, 0, 0, 0);
            bf16x8v pk[2];
#pragma unroll
            for (int r = 0; r < 16; ++r) {
                const int key = sb + 8 * (r >> 2) + 4 * hi + (r & 3); const bool valid = key < t;
                const float w = valid ? fast_exp(zz[r] + R[r]) : 0.f;
                pk[r >> 3][r & 7] = (short)f2bf(w);
            }
            cr = __shfl(R[0], ln);
#pragma unroll
            for (int ks2 = 0; ks2 < 2; ++ks2) {
                bf16x8v v0, v1;
                { const v4u q = (v4u){va[0][ks2].x, va[0][ks2].y, vb[0][ks2].x, vb[0][ks2].y}; v0 = __builtin_bit_cast(bf16x8v, q); }
                { const v4u q = (v4u){va[1][ks2].x, va[1][ks2].y, vb[1][ks2].x, vb[1][ks2].y}; v1 = __builtin_bit_cast(bf16x8v, q); }
                o0 = __builtin_amdgcn_mfma_f32_32x32x16_bf16(v0, pk[ks2], o0, 0, 0, 0);
                o1 = __builtin_amdgcn_mfma_f32_32x32x16_bf16(v1, pk[ks2], o1, 0, 0, 0);
            }
            if (__all(cr < -110.f)) break;
        }
        bf16* op = MIX + ((size_t)(b * SEQ + t)) * D + h * 64 + 4 * hi;
#pragma unroll
        for (int i = 0; i < 4; ++i) {
            v2u w0; w0.x = pk2(o0[4 * i], o0[4 * i + 1]); w0.y = pk2(o0[4 * i + 2], o0[4 * i + 3]); *(v2u*)(op + 8 * i) = w0;
            v2u w1; w1.x = pk2(o1[4 * i], o1[4 * i + 1]); w1.y = pk2(o1[4 * i + 2], o1[4 * i + 3]); *(v2u*)(op + 32 + 8 * i) = w1;
        }
    }
}

__device__ __forceinline__ void pool_simple(const bf16* Hb, bf16* MIX, const float* pool_w, const float* pool_scale, LAS float* P, int bid, int G, int tid) {
    for (int unit = bid; unit < (M / 32) * 4; unit += G) {
        const int g = unit & 3, row0 = (unit >> 2) * 32, t0 = row0 & (SEQ - 1), w = 2 << g;
        for (int e = tid; e < 32 * 128; e += NT) {
            const int r = e >> 7, c = e & 127, t = t0 + r;
            const bf16* up = Hb + (size_t)(row0 + r) * DIN + 1536 + g * 128 + c;
            float sum = 0.f;
            for (int j = 0; j < w; ++j) if (t - j >= 0) sum += bf2f(*(up - (size_t)j * DIN));
            const int cnt = (t + 1) < w ? (t + 1) : w;
            P[r * 128 + c] = sum / (float)cnt - bf2f(*up);
        }
        __syncthreads();
        const int d = tid & 127, rq = tid >> 7;
        float acc[8];
#pragma unroll
        for (int i = 0; i < 8; ++i) acc[i] = 0.f;
        const float* wp = pool_w + (size_t)g * 128 * 128 + d;
        for (int c = 0; c < 128; ++c) { const float wv = wp[(size_t)c * 128];
#pragma unroll
            for (int i = 0; i < 8; ++i) acc[i] += P[(rq * 8 + i) * 128 + c] * wv; }
        const float sc = pool_scale[g * 128 + d];
#pragma unroll
        for (int i = 0; i < 8; ++i) MIX[(size_t)(row0 + rq * 8 + i) * D + 512 + g * 128 + d] = (bf16)f2bf(acc[i] * sc);
        __syncthreads();
    }
}
__device__ __forceinline__ void conv_simple(const bf16* Hb, bf16* MIX, const float* dw, const float* ln_g, const float* ln_b, LAS float* hh, int bid, int G, int tid, int wave, int lane) {
    for (int unit = bid; unit < M / 32; unit += G) {
        const int row0 = unit * 32, t0 = row0 & (SEQ - 1);
        for (int e = tid; e < 62 * 512; e += NT) {
            const int r = e >> 9, c = e & 511, t = t0 - 30 + r;
            float val = 0.f;
            if (t >= 0) { const bf16* p = Hb + (size_t)(row0 - 30 + r) * DIN + c; val = bf2f(p[0]) * sigmoidf_(bf2f(p[512])); }
            hh[r * 512 + c] = val;
        }
        __syncthreads();
        {
            const int c = tid;
            float wk[31];
#pragma unroll
            for (int k = 0; k < 31; ++k) wk[k] = dw[k * 512 + c];
            for (int i = 0; i < 32; ++i) {
                float y = 0.f;
#pragma unroll
                for (int k = 0; k < 31; ++k) y += wk[k] * hh[(i + k) * 512 + c];
                hh[i * 512 + c] = y;
            }
        }
        __syncthreads();
        for (int i = wave * 4; i < wave * 4 + 4; ++i) {
            float v[8]; float s = 0.f;
#pragma unroll
            for (int j = 0; j < 8; ++j) { v[j] = hh[i * 512 + lane + 64 * j]; s += v[j]; }
            const float mean = wave_sum(s) * (1.f / 512.f); float s2 = 0.f;
#pragma unroll
            for (int j = 0; j < 8; ++j) { v[j] -= mean; s2 += v[j] * v[j]; }
            const float rstd = 1.f / sqrtf(wave_sum(s2) * (1.f / 512.f) + LN_EPS);
#pragma unroll
            for (int j = 0; j < 8; ++j) { const int c = lane + 64 * j; const float y = v[j] * rstd * ln_g[c] + ln_b[c];
                MIX[(size_t)(row0 + i) * D + c] = (bf16)f2bf(siluf_(y)); }
        }
        __syncthreads();
    }
}
__device__ __forceinline__ void sg_simple(const bf16* Hb, bf16* MIX, const float* ln_g, const float* ln_b, const float* sg_w, const float* sg_b, LAS float* V, LAS float* ST,
                                          int bid, int G, int tid, int wave, int lane) {
    for (int unit = bid; unit < (M / 128) * 4; unit += G) {
        const int g = unit & 3, row0 = (unit >> 2) * 128;
        for (int r = wave * 16; r < wave * 16 + 16; ++r) {
            const bf16* vp = Hb + (size_t)(row0 + r) * DIN + 1536;
            float v[8]; float s = 0.f;
#pragma unroll
            for (int j = 0; j < 8; ++j) { v[j] = gelu_tanh(bf2f(vp[lane + 64 * j])); s += v[j]; }
            const float mean = wave_sum(s) * (1.f / 512.f); float s2 = 0.f;
#pragma unroll
            for (int j = 0; j < 8; ++j) { const float dlt = v[j] - mean; s2 += dlt * dlt; }
            const float rstd = 1.f / sqrtf(wave_sum(s2) * (1.f / 512.f) + LN_EPS);
            if (lane == 0) { ST[2 * r] = mean; ST[2 * r + 1] = rstd; }
        }
        __syncthreads();
        for (int e = tid; e < 128 * 128; e += NT) {
            const int s = e >> 7, d = e & 127, c = g * 128 + d;
            const float v = gelu_tanh(bf2f(Hb[(size_t)(row0 + s) * DIN + 1536 + c]));
            V[s * 128 + d] = (v - ST[2 * s]) * ST[2 * s + 1] * ln_g[c] + ln_b[c];
        }
        __syncthreads();
        {
            const int d = tid & 127, tq = tid >> 7;
            for (int i = 0; i < 32; ++i) {
                const int t = tq + 4 * i;
                const float* wrow = sg_w + ((size_t)g * 128 + t) * 128;
                float acc = 0.f;
                for (int s = 0; s <= t; ++s) acc += wrow[s] * V[s * 128 + d];
                const float sv = acc + sg_b[g * 128 + t];
                const float uu = gelu_tanh(bf2f(Hb[(size_t)(row0 + t) * DIN + 1024 + g * 128 + d]));
                MIX[(size_t)(row0 + t) * D + 512 + g * 128 + d] = (bf16)f2bf(uu * sv);
            }
        }
        __syncthreads();
    }
}


constexpr int LDP = 136;
__device__ __forceinline__ bf16x8v lds_frag(LAS unsigned char* tile, int row, int ks, int fq) { return *(const LAS bf16x8v*)(tile + ((row * LDP + 32 * ks + 8 * fq) * 2)); }
__device__ __forceinline__ f32x4 mma16(bf16x8v wf, bf16x8v xf, f32x4 acc) { return __builtin_amdgcn_mfma_f32_16x16x32_bf16(wf, xf, acc, 0, 0, 0); }

__device__ __forceinline__ void pool_mfma(const bf16* Hb, bf16* MIX, const bf16* PWT, const float* pool_scale, LAS unsigned char* lds, int bid, int G, int tid, int wave, int lane) {
    LAS unsigned char* U = lds; LAS unsigned char* XP = lds + 36864; LAS unsigned char* WT = lds + 36864 + 34816;
    const int fr = lane & 15, fq = lane >> 4;
    for (int unit = bid; unit < (M / 128) * 4; unit += G) {
        const int g = unit & 3, row0 = (unit >> 2) * 128, t0 = row0 & (SEQ - 1), w = 2 << g;
        for (int e = tid; e < 143 * 16; e += NT) {
            const int r = e >> 4, ch = e & 15; v4u v = (v4u){0u, 0u, 0u, 0u};
            if (t0 - 15 + r >= 0) v = *(const v4u*)(Hb + (size_t)(row0 - 15 + r) * DIN + 1536 + g * 128 + 8 * ch);
            *(LAS v4u*)(U + (r * 128 + 8 * ch) * 2) = v;
        }
        for (int e = tid; e < 128 * 16; e += NT) {
            const int d = e >> 4, ch = e & 15;
            *(LAS v4u*)(WT + (d * LDP + 8 * ch) * 2) = *(const v4u*)(PWT + (size_t)g * 16384 + d * 128 + 8 * ch);
        }
        __syncthreads();
        {
            const int cp = tid & 63, m0 = (tid >> 6) * 16;
            float s0 = 0.f, s1 = 0.f;
            for (int j = 1; j < w; ++j) { const unsigned uu = *(const LAS unsigned*)(U + ((m0 + 15 - j) * 128 + 2 * cp) * 2); s0 += bflo(uu); s1 += bfhi(uu); }
            for (int m = m0; m < m0 + 16; ++m) {
                const unsigned uu = *(const LAS unsigned*)(U + ((m + 15) * 128 + 2 * cp) * 2); const float u0 = bflo(uu), u1 = bfhi(uu);
                s0 += u0; s1 += u1;
                const int t = t0 + m; const float inv = 1.0f / (float)((t + 1) < w ? (t + 1) : w);
                *(LAS unsigned*)(XP + (m * LDP + 2 * cp) * 2) = pk2(s0 * inv - u0, s1 * inv - u1);
                const unsigned uo = *(const LAS unsigned*)(U + ((m + 16 - w) * 128 + 2 * cp) * 2); s0 -= bflo(uo); s1 -= bfhi(uo);
            }
        }
        __syncthreads();
        {
            const int m0 = wave * 16;
            bf16x8v xf[4];
#pragma unroll
            for (int ks = 0; ks < 4; ++ks) xf[ks] = lds_frag(XP, m0 + fr, ks, fq);
            bf16* orow = MIX + (size_t)(row0 + m0 + fr) * D + 512 + g * 128 + 4 * fq;
#pragma unroll
            for (int n = 0; n < 8; ++n) {
                f32x4 acc = (f32x4){0.f, 0.f, 0.f, 0.f};
#pragma unroll
                for (int ks = 0; ks < 4; ++ks) acc = mma16(lds_frag(WT, 16 * n + fr, ks, fq), xf[ks], acc);
                const f32x4 sc = *(const f32x4*)(pool_scale + g * 128 + 16 * n + 4 * fq);
                v2u o; o.x = pk2(acc[0] * sc[0], acc[1] * sc[1]); o.y = pk2(acc[2] * sc[2], acc[3] * sc[3]);
                *(v2u*)(orow + 16 * n) = o;
            }
        }
        __syncthreads();
    }
}
__device__ __forceinline__ void sg_mfma(const bf16* Hb, bf16* MIX, const float* ln_g, const float* ln_b, const bf16* SGW, const float* sg_b, LAS unsigned char* lds,
                                        int bid, int G, int tid, int wave, int lane) {
    LAS unsigned char* WM = lds; LAS unsigned char* VTt = lds + 34816; LAS float* ST = (LAS float*)(lds + 69632);
    const int fr = lane & 15, fq = lane >> 4;
    for (int unit = bid; unit < (M / 128) * 4; unit += G) {
        const int g = unit & 3, row0 = (unit >> 2) * 128;
        for (int r = wave * 16; r < wave * 16 + 16; ++r) {
            const v4u q = *(const v4u*)(Hb + (size_t)(row0 + r) * DIN + 1536 + 8 * lane);
            float v[8]; v[0] = gelu_tanh(bflo(q.x)); v[1] = gelu_tanh(bfhi(q.x)); v[2] = gelu_tanh(bflo(q.y)); v[3] = gelu_tanh(bfhi(q.y));
            v[4] = gelu_tanh(bflo(q.z)); v[5] = gelu_tanh(bfhi(q.z)); v[6] = gelu_tanh(bflo(q.w)); v[7] = gelu_tanh(bfhi(q.w));
            float s = 0.f;
#pragma unroll
            for (int j = 0; j < 8; ++j) s += v[j];
            const float mean = wave_sum(s) * (1.f / 512.f); float s2 = 0.f;
#pragma unroll
            for (int j = 0; j < 8; ++j) { const float dlt = v[j] - mean; s2 += dlt * dlt; }
            const float rstd = 1.f / sqrtf(wave_sum(s2) * (1.f / 512.f) + LN_EPS);
            if (lane == 0) { ST[2 * r] = mean; ST[2 * r + 1] = rstd; }
        }
        for (int e = tid; e < 128 * 16; e += NT) {
            const int t = e >> 4, ch = e & 15;
            *(LAS v4u*)(WM + (t * LDP + 8 * ch) * 2) = *(const v4u*)(SGW + (size_t)g * 16384 + t * 128 + 8 * ch);
        }
        __syncthreads();
        for (int e = tid; e < 64 * 128; e += NT) {
            const int d = e & 127, sp = e >> 7, c = g * 128 + d;
            const bf16* vp = Hb + (size_t)(row0 + 2 * sp) * DIN + 1536 + c;
            const float gg = ln_g[c], bb = ln_b[c];
            const float v0 = (gelu_tanh(bf2f(vp[0])) - ST[4 * sp]) * ST[4 * sp + 1] * gg + bb;
            const float v1 = (gelu_tanh(bf2f(vp[DIN])) - ST[4 * sp + 2]) * ST[4 * sp + 3] * gg + bb;
            *(LAS unsigned*)(VTt + (d * LDP + 2 * sp) * 2) = pk2(v0, v1);
        }
        __syncthreads();
        {
            const int m0 = wave * 16, nks = (wave >> 1) + 1;
            bf16x8v xf[4];
#pragma unroll
            for (int ks = 0; ks < 4; ++ks) xf[ks] = lds_frag(WM, m0 + fr, ks, fq);
            const int t = m0 + fr; const float bt = sg_b[g * 128 + t];
            const bf16* urow = Hb + (size_t)(row0 + t) * DIN + 1024 + g * 128 + 4 * fq;
            bf16* orow = MIX + (size_t)(row0 + t) * D + 512 + g * 128 + 4 * fq;
#pragma unroll
            for (int n = 0; n < 8; ++n) {
                f32x4 acc = (f32x4){0.f, 0.f, 0.f, 0.f};
#pragma unroll
                for (int ks = 0; ks < 4; ++ks) if (ks < nks) acc = mma16(lds_frag(VTt, 16 * n + fr, ks, fq), xf[ks], acc);
                const v2u uw = *(const v2u*)(urow + 16 * n);
                v2u o; o.x = pk2(gelu_tanh(bflo(uw.x)) * (acc[0] + bt), gelu_tanh(bfhi(uw.x)) * (acc[1] + bt));
                o.y = pk2(gelu_tanh(bflo(uw.y)) * (acc[2] + bt), gelu_tanh(bfhi(uw.y)) * (acc[3] + bt));
                *(v2u*)(orow + 16 * n) = o;
            }
        }
        __syncthreads();
    }
}
__device__ __forceinline__ void conv_opt(const bf16* Hb, bf16* MIX, const float* dw, const float* ln_g, const float* ln_b, LAS float* hh, int bid, int G, int tid, int wave, int lane) {
    for (int unit = bid; unit < M / 32; unit += G) {
        const int row0 = unit * 32, t0 = row0 & (SEQ - 1);
        for (int e = tid; e < 62 * 64; e += NT) {
            const int r = e >> 6, ch = e & 63;
            f32x4 lo4 = (f32x4){0.f, 0.f, 0.f, 0.f}, hi4 = lo4;
            if (t0 - 30 + r >= 0) {
                const bf16* p = Hb + (size_t)(row0 - 30 + r) * DIN + 8 * ch;
                const v4u a = *(const v4u*)p, gt = *(const v4u*)(p + 512);
                lo4[0] = bflo(a.x) * sigmoidf_(bflo(gt.x)); lo4[1] = bfhi(a.x) * sigmoidf_(bfhi(gt.x)); lo4[2] = bflo(a.y) * sigmoidf_(bflo(gt.y)); lo4[3] = bfhi(a.y) * sigmoidf_(bfhi(gt.y));
                hi4[0] = bflo(a.z) * sigmoidf_(bflo(gt.z)); hi4[1] = bfhi(a.z) * sigmoidf_(bfhi(gt.z)); hi4[2] = bflo(a.w) * sigmoidf_(bflo(gt.w)); hi4[3] = bfhi(a.w) * sigmoidf_(bfhi(gt.w));
            }
            *(LAS f32x4*)(hh + r * 512 + 8 * ch) = lo4; *(LAS f32x4*)(hh + r * 512 + 8 * ch + 4) = hi4;
        }
        __syncthreads();
        {
            const int c = tid;
            float wk[31];
#pragma unroll
            for (int k = 0; k < 31; ++k) wk[k] = dw[k * 512 + c];
            for (int i0 = 0; i0 < 32; i0 += 4) {
                float y0 = 0.f, y1 = 0.f, y2 = 0.f, y3 = 0.f;
#pragma unroll
                for (int k = 0; k < 34; ++k) {
                    const float v = hh[(i0 + k) * 512 + c];
                    if (k < 31) y0 += wk[k < 31 ? k : 0] * v;
                    if (k >= 1 && k < 32) y1 += wk[(k >= 1 && k < 32) ? k - 1 : 0] * v;
                    if (k >= 2 && k < 33) y2 += wk[(k >= 2 && k < 33) ? k - 2 : 0] * v;
                    if (k >= 3) y3 += wk[k >= 3 ? k - 3 : 0] * v;
                }
                hh[(i0 + 0) * 512 + c] = y0; hh[(i0 + 1) * 512 + c] = y1; hh[(i0 + 2) * 512 + c] = y2; hh[(i0 + 3) * 512 + c] = y3;
            }
        }
        __syncthreads();
        for (int i = wave * 4; i < wave * 4 + 4; ++i) {
            const f32x4 a = *(const LAS f32x4*)(hh + i * 512 + 8 * lane), b4 = *(const LAS f32x4*)(hh + i * 512 + 8 * lane + 4);
            float v[8] = {a[0], a[1], a[2], a[3], b4[0], b4[1], b4[2], b4[3]};
            float s = 0.f;
#pragma unroll
            for (int j = 0; j < 8; ++j) s += v[j];
            const float mean = wave_sum(s) * (1.f / 512.f); float s2 = 0.f;
#pragma unroll
            for (int j = 0; j < 8; ++j) { v[j] -= mean; s2 += v[j] * v[j]; }
            const float rstd = 1.f / sqrtf(wave_sum(s2) * (1.f / 512.f) + LN_EPS);
            const f32x4 g0 = *(const f32x4*)(ln_g + 8 * lane), g1 = *(const f32x4*)(ln_g + 8 * lane + 4), b0 = *(const f32x4*)(ln_b + 8 * lane), b1 = *(const f32x4*)(ln_b + 8 * lane + 4);
            v4u o;
            o.x = pk2(siluf_(v[0] * rstd * g0[0] + b0[0]), siluf_(v[1] * rstd * g0[1] + b0[1])); o.y = pk2(siluf_(v[2] * rstd * g0[2] + b0[2]), siluf_(v[3] * rstd * g0[3] + b0[3]));
            o.z = pk2(siluf_(v[4] * rstd * g1[0] + b1[0]), siluf_(v[5] * rstd * g1[1] + b1[1])); o.w = pk2(siluf_(v[6] * rstd * g1[2] + b1[2]), siluf_(v[7] * rstd * g1[3] + b1[3]));
            *(v4u*)(MIX + (size_t)(row0 + i) * D + 8 * lane) = o;
        }
        __syncthreads();
    }
}

struct Args { const float* in[25]; float* out; unsigned char* ws; int ph_lo, ph_hi; };
typedef const __attribute__((address_space(4))) Args* KArgP;
#define PHASE_ARGS() KArgP ap = (KArgP)__builtin_amdgcn_kernarg_segment_ptr(); asm volatile("" : "+s"(ap)); int zq = 0; asm volatile("s_mov_b32 %0, 0" : "=s"(zq)); \
    unsigned char* const ws = ap->ws + zq; (void)ws
__global__ void __launch_bounds__(NT, 2) mega_fwd(Args args) {
    extern __shared__ __attribute__((aligned(16))) unsigned char lds_raw[];
    cg::grid_group grid = cg::this_grid();
    LAS unsigned char* lds = (LAS unsigned char*)lds_raw;
    const int tid = threadIdx.x, lane = tid & 63, wave = __builtin_amdgcn_readfirstlane(tid >> 6);
    const int G = gridDim.x, bid = blockIdx.x;
    const int gw = bid * NWAVES + wave, NGW = G * NWAVES;
    const int lo = args.ph_lo, hi = args.ph_hi;
#ifndef DIS_MASK
#define DIS_MASK 0
#endif
#define RUN(k) (lo <= (k) && (k) < hi)
#define RUNJ(j) (!((DIS_MASK >> (j)) & 1) && RUN(pb + (j)))
#define SEAM(k) do { if (lo <= (k) && (k) + 1 < hi) grid.sync(); } while (0)
#define WSB(off) ((bf16*)(ws + (off)))

    if (!((DIS_MASK >> 8) & 1) && RUN(0)) {
        PHASE_ARGS();
        LAS float* scr = (LAS float*)(lds + wave * 16384);
        constexpr int NITEMS = 2 * (1024 + 512 + 1408 + 1408 + 1408 + 512 + 128) + 32;
        for (int it = gw; it < NITEMS; it += NGW) {
            int r = it;
#define TR(Wsrc, K_, N_, WTdst, ROWMAP) { const int nblk = (N_) / 32, cnt = ((K_) / 64) * nblk; if (r < cnt) { const int kb = r / nblk, n0 = (r % nblk) * 32; \
                transpose_item((Wsrc), (K_), (N_), (WTdst), kb, n0, (ROWMAP), scr, lane); continue; } r -= cnt; }
#define TR_LAYER(l) \
            TR(ap->in[(l) == 0 ? 2 : 6], D, DIN, WSB(WS_WIN) + (size_t)(l) * DIN * D, n0) \
            TR(ap->in[(l) == 0 ? 3 : 7], D, D, WSB(WS_WOUT) + (size_t)(l) * D * D, n0) \
            TR(ap->in[17] + (size_t)(l) * D * DFF, D, DFF, WSB(WS_WGU) + (size_t)(l) * 2 * DFF * D, (n0 / 128) * 256 + (n0 % 128)) \
            TR(ap->in[18] + (size_t)(l) * D * DFF, D, DFF, WSB(WS_WGU) + (size_t)(l) * 2 * DFF * D, (n0 / 128) * 256 + 128 + (n0 % 128)) \
            TR(ap->in[19] + (size_t)(l) * DFF * D, DFF, D, WSB(WS_WD) + (size_t)(l) * D * DFF, n0) \
            TR(ap->in[23] + (size_t)(l) * D * D, D, D, WSB(WS_WPG) + (size_t)(l) * D * D, n0) \
            TR(ap->in[22] + (size_t)(l) * PLE * D, PLE, D, WSB(WS_WPP) + (size_t)(l) * D * PLE, n0)
            TR_LAYER(0)
            TR_LAYER(1)
            TR(ap->in[4] + 0 * 16384, 128, 128, WSB(WS_POOLWT) + 0 * 16384, n0) TR(ap->in[4] + 1 * 16384, 128, 128, WSB(WS_POOLWT) + 1 * 16384, n0)
            TR(ap->in[4] + 2 * 16384, 128, 128, WSB(WS_POOLWT) + 2 * 16384, n0) TR(ap->in[4] + 3 * 16384, 128, 128, WSB(WS_POOLWT) + 3 * 16384, n0)
#undef TR_LAYER
#undef TR
        }
        const size_t gtid = (size_t)bid * NT + tid, gthreads = (size_t)G * NT;
        if (gtid < 8192) {
            const int ts = (int)gtid, t = (ts >> 4) & 127, s0 = (ts & 15) * 8; const float* src = ap->in[13] + (size_t)ts * 8;
            const f32x4 a = *(const f32x4*)src, b = *(const f32x4*)(src + 4);
            v4u o; o.x = pk2(s0 + 0 <= t ? a[0] : 0.f, s0 + 1 <= t ? a[1] : 0.f); o.y = pk2(s0 + 2 <= t ? a[2] : 0.f, s0 + 3 <= t ? a[3] : 0.f);
            o.z = pk2(s0 + 4 <= t ? b[0] : 0.f, s0 + 5 <= t ? b[1] : 0.f); o.w = pk2(s0 + 6 <= t ? b[2] : 0.f, s0 + 7 <= t ? b[3] : 0.f);
            *(v4u*)(WSB(WS_SGW) + (size_t)ts * 8) = o;
        }
        cvt_f32_bf16(ap->in[0], WSB(WS_XB), (size_t)M * D / 8, gtid, gthreads);
        cvt_f32_bf16(ap->in[1], (bf16*)ap->out, (size_t)2 * M * PLE / 8, gtid, gthreads);
    }
    SEAM(0);

    for (int l = 0; l < 2; ++l) {
        const int pb = 1 + 8 * l;
        if (RUNJ(0)) {
            PHASE_ARGS();
            bf16* VT = (bf16*)ap->out + (size_t)2 * M * PLE;
            { EpiInProj E{WSB(WS_H), l == 0 ? VT : (bf16*)nullptr}; run_gemm(lds, l == 0 ? WSB(WS_XB) : WSB(WS_MIX), WSB(WS_WIN) + (size_t)l * DIN * D, DIN, D, E, G, bid); }
            if (l == 0) {
                for (int q = 0; q < 2; ++q) { pg8::EpiBf16<0> E{WSB(WS_PP) + (size_t)q * M * D, D, nullptr, 0, 0, 1.f};
                    run_gemm(lds, (bf16*)ap->out + (size_t)q * M * PLE, WSB(WS_WPP) + (size_t)q * D * PLE, D, PLE, E, G, bid); }
            }
        }
        SEAM(pb + 0);
        if (RUNJ(1)) {
            PHASE_ARGS();
            const bf16* Hq = WSB(WS_H); bf16* Mq = WSB(WS_MIX); const int tidq = tid + zq, laneq = lane + zq;
            if (l == 0) {
                attn_mfma(Hq, (bf16*)ap->out + (size_t)2 * M * PLE, Mq, gw, NGW, laneq);
                pool_mfma(Hq, Mq, WSB(WS_POOLWT), ap->in[5], lds, bid, G, tidq, wave, laneq);
            } else {
                conv_opt(Hq, Mq, ap->in[8], ap->in[9], ap->in[10], (LAS float*)lds, bid, G, tidq, wave, laneq);
                sg_mfma(Hq, Mq, ap->in[11], ap->in[12], WSB(WS_SGW), ap->in[14], lds, bid, G, tidq, wave, laneq);
            }
        }
        SEAM(pb + 1);
        if (RUNJ(2)) { PHASE_ARGS(); EpiResid E{l == 0 ? ap->in[0] : (const float*)ap->out, ap->out, D, ALPHA}; run_gemm(lds, WSB(WS_MIX), WSB(WS_WOUT) + (size_t)l * D * D, D, D, E, G, bid); }
        SEAM(pb + 2);
        if (RUNJ(3)) { PHASE_ARGS(); ln_phase(ap->out, WSB(WS_XB), ap->in[15] + l * D, ap->in[16] + l * D, gw, NGW, lane + zq); }
        SEAM(pb + 3);
        if (RUNJ(4)) { PHASE_ARGS(); EpiSwiglu E{WSB(WS_HFF), DFF}; run_gemm(lds, WSB(WS_XB), WSB(WS_WGU) + (size_t)l * 2 * DFF * D, 2 * DFF, D, E, G, bid); }
        SEAM(pb + 4);
        if (RUNJ(5)) { PHASE_ARGS(); EpiResid E{ap->out, ap->out, D, ALPHA}; run_gemm(lds, WSB(WS_HFF), WSB(WS_WD) + (size_t)l * D * DFF, D, DFF, E, G, bid); }
        SEAM(pb + 5);
        if (RUNJ(6)) { PHASE_ARGS(); ln_phase(ap->out, WSB(WS_XB), ap->in[20] + l * D, ap->in[21] + l * D, gw, NGW, lane + zq); }
        SEAM(pb + 6);
        if (RUNJ(7)) { PHASE_ARGS(); EpiPle E{ap->in[24] + l * D, WSB(WS_PP) + (size_t)l * M * D, ap->out, l == 0 ? WSB(WS_MIX) : (bf16*)nullptr}; run_gemm(lds, WSB(WS_XB), WSB(WS_WPG) + (size_t)l * D * D, D, D, E, G, bid); }
        SEAM(pb + 7);
    }
#undef RUN
#undef RUNJ
#undef SEAM
}

extern "C" void kernel_launch(void* const* d_in, const int* in_sizes, int n_in, void* d_out, int out_size, void* d_ws, size_t ws_size, hipStream_t stream) {
    static int grid = 0;
    if (grid == 0) {
        if (n_in != 25 || out_size != M * D || ws_size < WS_END) { fprintf(stderr, "kernel_launch: unexpected shapes (n_in %d, out %d, ws %zu)\n", n_in, out_size, ws_size); grid = -1; return; }
        int dev = 0, cus = 0, per_cu = 0;
        hipGetDevice(&dev); hipDeviceGetAttribute(&cus, hipDeviceAttributeMultiprocessorCount, dev);
        if (hipFuncSetAttribute((const void*)mega_fwd, hipFuncAttributeMaxDynamicSharedMemorySize, LDS_BYTES) != hipSuccess) { fprintf(stderr, "kernel_launch: hipFuncSetAttribute failed\n"); grid = -1; return; }
        if (hipOccupancyMaxActiveBlocksPerMultiprocessor(&per_cu, (const void*)mega_fwd, NT, LDS_BYTES) != hipSuccess || per_cu < 1) { fprintf(stderr, "kernel_launch: occupancy query gives %d\n", per_cu); per_cu = 1; }
        (void)hipGetLastError();
        grid = cus * (per_cu > 1 ? 1 : per_cu);
        fprintf(stderr, "kernel_launch: grid %d (cus %d, per_cu %d)\n", grid, cus, per_cu);
    }
    if (grid < 0) return;
    Args a{};
    for (int i = 0; i < 25; ++i) a.in[i] = (const float*)d_in[i];
    a.out = (float*)d_out; a.ws = (unsigned char*)d_ws;
#if MK_PER_PHASE
    for (int k = 0; k < N_PHASES; ++k) { a.ph_lo = k; a.ph_hi = k + 1; hipLaunchKernelGGL(mega_fwd, dim3(grid), dim3(NT), LDS_BYTES, stream, a); }
#else
    a.ph_lo = 0; a.ph_hi = N_PHASES;
    void* kargs[] = {&a};
    hipError_t e = hipLaunchCooperativeKernel((const void*)mega_fwd, dim3(grid), dim3(NT), kargs, LDS_BYTES, stream);
    if (e != hipSuccess) fprintf(stderr, "kernel_launch: cooperative launch failed: %s (grid %d)\n", hipGetErrorString(e), grid);
#endif
}
```
